# Optimizing an MI355X kernel written in HIP

```python
import math
import jax, jax.numpy as jnp
from jax import lax
import numpy as np

D_MODEL = 2048
BATCH = 4
SEQ = 8192
DEPTH = 1

N_HEADS_A = 16
D_LAT = 256
D_HEAD_A = 128
D_ATTN = N_HEADS_A * D_HEAD_A
N_HEADS_IDX = 16
D_IDX = 64
TOPK_MAX = 256
Q_BLOCK = 128
D_RNN = 2048
N_BLK_RNN = 16
D_BLK_RNN = D_RNN // N_BLK_RNN
CONV_W = 4
LRU_C = 8.0
N_BUCKETS = 32
MAX_DIST = 128
ALPHA = (2 * DEPTH) ** 0.25
BETA = (8 * DEPTH) ** -0.25
LN_EPS = 1e-5

IN_SIZES = (N_HEADS_A * D_LAT, D_LAT, D_ATTN, N_HEADS_IDX * D_IDX, D_IDX, N_HEADS_IDX,
            D_RNN, D_RNN, D_MODEL, D_MODEL)
D_IN = sum(IN_SIZES)
SPLIT_POINTS = tuple(int(v) for v in np.cumsum(IN_SIZES)[:-1])

kernel_name = "hybrid_dsa_rglru_gated_deepnorm"


def _layernorm(x, g, b):
    xf = x.astype(jnp.float32)
    mu = jnp.mean(xf, axis=-1, keepdims=True)
    var = jnp.mean(jnp.square(xf - mu), axis=-1, keepdims=True)
    return ((xf - mu) * lax.rsqrt(var + LN_EPS)).astype(x.dtype) * g + b


def _rmsnorm(x, g):
    xf = x.astype(jnp.float32)
    return (xf * lax.rsqrt(jnp.mean(jnp.square(xf), axis=-1, keepdims=True) + LN_EPS)).astype(x.dtype) * g


def _t5_bucket(dist):
    n = jnp.maximum(dist, 0)
    max_exact = N_BUCKETS // 2
    nf = jnp.maximum(n, 1).astype(jnp.float32)
    large = max_exact + (jnp.log(nf / max_exact) / math.log(MAX_DIST / max_exact)
                         * (N_BUCKETS - max_exact)).astype(jnp.int32)
    large = jnp.minimum(large, N_BUCKETS - 1)
    return jnp.where(n < max_exact, n, large)


def _sparse_attention(q_lat, c_kv, q_idx, k_idx, w_idx, rel_bias, w_uv):
    B, T = q_lat.shape[:2]
    K = min(TOPK_MAX, T // 4)
    nb = T // Q_BLOCK
    key_pos = jnp.arange(T, dtype=jnp.int32)
    idx_scale = (D_IDX ** -0.5) * (N_HEADS_IDX ** -0.5)
    att_scale = D_LAT ** -0.5

    def blockify(a):
        return jnp.moveaxis(a.reshape((B, nb, Q_BLOCK) + a.shape[2:]), 1, 0)

    def one_block(args):
        qb, qib, wb, blk = args
        q_pos = blk * Q_BLOCK + jnp.arange(Q_BLOCK, dtype=jnp.int32)
        s = jax.nn.relu(jnp.einsum('bqhd,bsd->bqhs', qib, k_idx).astype(jnp.float32))
        score = jnp.einsum('bqhs,bqh->bqs', s, wb.astype(jnp.float32)) * idx_scale
        causal = key_pos[None, :] <= q_pos[:, None]
        score = jnp.where(causal[None], score, -jnp.inf)
        _, sel = lax.top_k(score, K)
        c_sel = jax.vmap(lambda c_b, i_b: c_b[i_b])(c_kv, sel)
        logits = jnp.einsum('bqhd,bqkd->bqhk', qb, c_sel).astype(jnp.float32) * att_scale
        dist = q_pos[None, :, None] - sel
        bias = rel_bias[_t5_bucket(dist)]
        logits = logits + jnp.moveaxis(bias, -1, 2).astype(jnp.float32)
        logits = jnp.where((dist >= 0)[:, :, None, :], logits, -jnp.inf)
        p = jax.nn.softmax(logits, axis=-1).astype(c_sel.dtype)
        o = jnp.einsum('bqhk,bqkd->bqhd', p, c_sel)
        o = jnp.einsum('bqhd,hde->bqhe', o, w_uv)
        return o.reshape(B, Q_BLOCK, D_ATTN)

    out = lax.map(one_block, (blockify(q_lat), blockify(q_idx), blockify(w_idx),
                              jnp.arange(nb, dtype=jnp.int32)))
    return jnp.moveaxis(out, 0, 1).reshape(B, T, D_ATTN)


def _rglru(xr, conv_w, conv_b, w_gate_a, b_gate_a, w_gate_x, b_gate_x, lru_lambda):
    B, T, _ = xr.shape
    xp = jnp.pad(xr, ((0, 0), (CONV_W - 1, 0), (0, 0)))
    xc = conv_b + sum(conv_w[k] * xp[:, k:k + T] for k in range(CONV_W))
    xb = xc.reshape(B, T, N_BLK_RNN, D_BLK_RNN)
    r = jax.nn.sigmoid(jnp.einsum('btnd,nde->btne', xb, w_gate_a).reshape(B, T, D_RNN) + b_gate_a)
    i = jax.nn.sigmoid(jnp.einsum('btnd,nde->btne', xb, w_gate_x).reshape(B, T, D_RNN) + b_gate_x)
    log_a = -LRU_C * r.astype(jnp.float32) * jax.nn.softplus(-lru_lambda.astype(jnp.float32))
    a = jnp.exp(log_a)
    mult = jnp.sqrt(-jnp.expm1(2.0 * log_a))
    mult = jnp.where(jnp.arange(T)[None, :, None] == 0, 1.0, mult)
    b = mult * (i * xc).astype(jnp.float32)

    def combine(left, right):
        a1, b1 = left
        a2, b2 = right
        return a1 * a2, a2 * b1 + b2

    _, h = lax.associative_scan(combine, (a, b), axis=1)
    return h.astype(xr.dtype)


def setup_inputs(seed: int = 0) -> dict:
    key = jax.random.key(seed)
    ks = jax.random.split(key, 18)
    f32 = jnp.float32
    nrm = lambda k, shape, s: jax.random.normal(k, shape, f32) * s
    u = jax.random.uniform(ks[9], (DEPTH, D_RNN), f32, 0.9, 0.999)
    p = u ** (1.0 / LRU_C)
    lru_lambda = jnp.log(p) - jnp.log1p(-p)
    return {
        "x": jax.random.normal(ks[0], (BATCH, SEQ, D_MODEL), f32),
        "w_in": nrm(ks[1], (DEPTH, D_MODEL, D_IN), D_MODEL ** -0.5),
        "kv_norm_g": 1.0 + nrm(ks[2], (DEPTH, D_LAT), 0.02),
        "w_uv": nrm(ks[3], (DEPTH, N_HEADS_A, D_LAT, D_HEAD_A), D_LAT ** -0.5),
        "w_branch_a": nrm(ks[4], (DEPTH, D_ATTN, D_MODEL), BETA * D_ATTN ** -0.5),
        "conv_w": nrm(ks[5], (DEPTH, CONV_W, D_RNN), CONV_W ** -0.5),
        "conv_b": nrm(ks[6], (DEPTH, D_RNN), 0.02),
        "w_gate_a": nrm(ks[7], (DEPTH, N_BLK_RNN, D_BLK_RNN, D_BLK_RNN), D_BLK_RNN ** -0.5),
        "b_gate_a": nrm(ks[8], (DEPTH, D_RNN), 0.02),
        "w_gate_x": nrm(ks[10], (DEPTH, N_BLK_RNN, D_BLK_RNN, D_BLK_RNN), D_BLK_RNN ** -0.5),
        "b_gate_x": nrm(ks[11], (DEPTH, D_RNN), 0.02),
        "lru_lambda": lru_lambda,
        "w_branch_b": nrm(ks[12], (DEPTH, D_RNN, D_MODEL), BETA * D_RNN ** -0.5),
        "rel_bias": nrm(ks[13], (N_BUCKETS, N_HEADS_A), 0.5),
        "w_out": nrm(ks[14], (DEPTH, D_MODEL, D_MODEL), BETA * D_MODEL ** -0.5),
        "ln_g": 1.0 + nrm(ks[15], (DEPTH, D_MODEL), 0.02),
        "ln_b": nrm(ks[16], (DEPTH, D_MODEL), 0.02),
    }


def reference(x, w_in, kv_norm_g, w_uv, w_branch_a, conv_w, conv_b, w_gate_a, b_gate_a,
              w_gate_x, b_gate_x, lru_lambda, w_branch_b, rel_bias, w_out, ln_g, ln_b):
    B, T, _ = x.shape
    for l in range(DEPTH):
        proj = jnp.einsum('btd,dc->btc', x, w_in[l])
        (q_lat, c_kv, attn_gate, q_idx, k_idx, w_idx,
         x_rnn, rnn_gate, g_a, g_b) = jnp.split(proj, SPLIT_POINTS, axis=-1)
        q_lat = q_lat.reshape(B, T, N_HEADS_A, D_LAT)
        c_kv = _rmsnorm(c_kv, kv_norm_g[l])
        q_idx = q_idx.reshape(B, T, N_HEADS_IDX, D_IDX)
        attn = _sparse_attention(q_lat, c_kv, q_idx, k_idx, w_idx, rel_bias, w_uv[l])
        branch_a = jnp.einsum('btc,cd->btd', attn * jax.nn.silu(attn_gate), w_branch_a[l])
        h = _rglru(x_rnn, conv_w[l], conv_b[l], w_gate_a[l], b_gate_a[l],
                   w_gate_x[l], b_gate_x[l], lru_lambda[l])
        branch_b = jnp.einsum('btc,cd->btd', h * jax.nn.silu(rnn_gate), w_branch_b[l])
        merged = jax.nn.sigmoid(g_a) * branch_a + jax.nn.sigmoid(g_b) * branch_b
        sub = jnp.einsum('btd,de->bte', merged, w_out[l])
        x = _layernorm(ALPHA * x + sub, ln_g[l], ln_b[l])
    return x
```

```cpp
#include <hip/hip_runtime.h>
#include <hip/hip_cooperative_groups.h>
#include <cstdio>
#include <cstdint>
namespace cg = cooperative_groups;

#ifndef DBG
#define DBG 0
#endif
#ifndef N_LAUNCHES
#define N_LAUNCHES 1
#endif

namespace pg8 {
#define PG8_LAS __attribute__((address_space(3)))
typedef unsigned short bf16_t;
typedef short bf16x8 __attribute__((ext_vector_type(8)));
typedef float f32x4 __attribute__((ext_vector_type(4)));
typedef unsigned u32x4 __attribute__((ext_vector_type(4)));
constexpr int BM = 256, BK = 64, HALF = 128, HTB = HALF * BK * 2, STAGE_BYTES = 8 * HTB, NXCD = 8, WGM = 4;

__host__ __device__ __forceinline__ int lds_byte(int r, int c) { const int st = (r >> 4) * 2 + (c >> 5), rr = r & 15, cc = c & 31, ob = rr * 64 + cc * 2; return st * 1024 + (ob ^ (((ob >> 9) & 1) << 5)); }
__host__ __device__ __forceinline__ void stage_rc(int b, int& R, int& C) { const int st = b / 1024, sb = b % 1024, swz = sb ^ (((sb >> 9) & 1) << 5); R = (st >> 1) * 16 + swz / 64; C = (st & 1) * 32 + (swz % 64) / 2; }
__host__ __device__ __forceinline__ int perm32(int rho) { const int n = rho >> 4, i = rho & 15; return 8 * (i >> 2) + 4 * n + (i & 3); }

struct Unit { int pm, pn; };
struct Gemm { const bf16_t* A; const bf16_t* Bt; int K, lda, ldb, apn; };

struct StaticOrder {
    int nM, nN, nwg, G, c;
    __host__ __device__ __forceinline__ void init(int M, int N, int G_, int c_) { nM = M / BM; nN = N / BM; nwg = nM * nN; G = G_; c = c_; }
    __host__ __device__ __forceinline__ bool next(int i, Unit& u) const {
        const long L = (long)i * G + c; if (L >= nwg) return false;
        int wgid = (int)L; { const int q = nwg / NXCD, r = nwg % NXCD, xcd = wgid % NXCD, off = wgid / NXCD; wgid = (xcd < r ? xcd * (q + 1) : r * (q + 1) + (xcd - r) * q) + off; }
        const int nig = WGM * nN, gid = wgid / nig, fm = gid * WGM, gsz = (nM - fm) < WGM ? (nM - fm) : WGM;
        u.pm = fm + ((wgid % nig) % gsz); u.pn = (wgid % nig) / gsz; return true;
    }
};

__device__ __forceinline__ unsigned cvt_pk_bf16(float lo, float hi) { unsigned r; asm volatile("v_cvt_pk_bf16_f32 %0, %1, %2" : "=v"(r) : "v"(lo), "v"(hi)); return r; }

template <class Epi, bool BLKDIAG = false>
__device__ __forceinline__ void gemm_phase(PG8_LAS unsigned char* lds, const Gemm g, const StaticOrder& S, const Epi& E) {
    const int tid = threadIdx.x, wid = __builtin_amdgcn_readfirstlane(tid >> 6), lane = tid & 63, wr = wid >> 2, wc = wid & 3, fr = lane & 15, fq = lane >> 4;
    const int K = g.K, nt = K / BK;
    unsigned voffA[2], voffB[2];
#pragma unroll
    for (int i = 0; i < 2; ++i) { int R, C; stage_rc(tid * 16 + i * 8192, R, C); const int Rb = (R & ~31) + perm32(R & 31);
        voffA[i] = (unsigned)(R * g.lda + C) * 2u; voffB[i] = (unsigned)(Rb * g.ldb + C) * 2u; }
    const size_t kstep = (size_t)(BK * 2);
    const size_t hstepA = (size_t)HALF * g.lda * 2, hstepB = (size_t)HALF * g.ldb * 2;
    const size_t tstepA = 2 * hstepA, tstepB = 2 * hstepB;
    const unsigned ldsw = (unsigned)wid * 1024u;
    const int aoff = lds_byte(wr * 64 + fr, fq * 8), boff = lds_byte(wc * 32 + fr, fq * 8);
#define PG8_SA(b, h) (((b) * 2 + (h)) * HTB)
#define PG8_SB(b, h) ((4 + (b) * 2 + (h)) * HTB)
#define PG8_STAGE(bufoff, gbase, voff) do { _Pragma("unroll") for (int _i = 0; _i < 2; ++_i) \
        __builtin_amdgcn_global_load_lds((const unsigned*)((const char*)(gbase) + (voff)[_i]), (PG8_LAS unsigned*)(lds + (bufoff) + ldsw + _i * 8192), 16, 0, 0); } while (0)
#define PG8_LDA(dst, b, h) do { _Pragma("unroll") for (int m = 0; m < 4; ++m) _Pragma("unroll") for (int k = 0; k < 2; ++k) dst[m][k] = *(const PG8_LAS bf16x8*)(lds + PG8_SA(b, h) + aoff + m * 2048 + k * 1024); } while (0)
#define PG8_LDB(dst, b, h) do { _Pragma("unroll") for (int n = 0; n < 2; ++n) _Pragma("unroll") for (int k = 0; k < 2; ++k) dst[n][k] = *(const PG8_LAS bf16x8*)(lds + PG8_SB(b, h) + boff + n * 2048 + k * 1024); } while (0)
#define PG8_MMA(ai, bj, At, Bt) do { __builtin_amdgcn_s_setprio(1); _Pragma("unroll") for (int m = 0; m < 4; ++m) _Pragma("unroll") for (int n = 0; n < 2; ++n) _Pragma("unroll") for (int k = 0; k < 2; ++k) \
        acc[ai][bj][m][n] = __builtin_amdgcn_mfma_f32_16x16x32_bf16(Bt[n][k], At[m][k], acc[ai][bj][m][n], 0, 0, 0); __builtin_amdgcn_s_setprio(0); } while (0)
#define PG8_WAIT_V(n) asm volatile("s_waitcnt vmcnt(" #n ")" ::: "memory")
#define PG8_WAIT_L(n) asm volatile("s_waitcnt lgkmcnt(" #n ")" ::: "memory")
#define PG8_BAR __builtin_amdgcn_s_barrier()
#define PG8_SCHED __builtin_amdgcn_sched_barrier(0)
    Unit cur, nxt; int ui = 0;
    if (!S.next(0, cur)) return;
    f32x4 acc[2][2][4][2];
#pragma unroll
    for (int a = 0; a < 2; ++a)
#pragma unroll
        for (int b = 0; b < 2; ++b)
#pragma unroll
            for (int m = 0; m < 4; ++m)
#pragma unroll
                for (int n = 0; n < 2; ++n) acc[a][b][m][n] = (f32x4){0.f, 0.f, 0.f, 0.f};
    bf16x8 At[4][2], B0[2][2], B1[2][2];
    const char* cA = (const char*)g.A + (size_t)cur.pm * tstepA + (size_t)cur.pn * g.apn * 2; const char* cB = (const char*)g.Bt + (size_t)cur.pn * tstepB;
    PG8_STAGE(PG8_SB(0, 0), cB, voffB); PG8_STAGE(PG8_SB(0, 1), cB + hstepB, voffB); PG8_STAGE(PG8_SA(0, 0), cA, voffA); PG8_STAGE(PG8_SA(0, 1), cA + hstepA, voffA);
    if (wr == 1) PG8_BAR;
    PG8_WAIT_V(2); PG8_BAR;
    PG8_STAGE(PG8_SB(1, 0), cB + kstep, voffB); PG8_STAGE(PG8_SA(1, 0), cA + kstep, voffA); PG8_STAGE(PG8_SB(1, 1), cB + hstepB + kstep, voffB);
    PG8_WAIT_V(6); PG8_BAR;
    for (;;) {
        const bool has_next = S.next(ui + 1, nxt);
        const char* nA = has_next ? (const char*)g.A + (size_t)nxt.pm * tstepA + (size_t)nxt.pn * g.apn * 2 : cA; const char* nB = has_next ? (const char*)g.Bt + (size_t)nxt.pn * tstepB : cB;
        for (int t = 0; t < nt; t += 2) {
            const bool last = (t == nt - 2);
            const bool lo_ = BLKDIAG ? (t < nt / 2) : true, hi_ = BLKDIAG ? !lo_ : true;
            const char* a1 = cA + (size_t)(t + 1) * kstep;
            const char* a2 = last ? nA : cA + (size_t)(t + 2) * kstep; const char* b2 = last ? nB : cB + (size_t)(t + 2) * kstep;
            const char* a3 = a2 + kstep; const char* b3 = b2 + kstep;
            PG8_LDB(B0, 0, 0); PG8_LDB(B1, 0, 1); PG8_SCHED; PG8_LDA(At, 0, 0); PG8_STAGE(PG8_SA(1, 1), a1 + hstepA, voffA);
            PG8_WAIT_V(8); PG8_WAIT_L(0); PG8_BAR; if (lo_) PG8_MMA(0, 0, At, B0); if (hi_) PG8_MMA(0, 1, At, B1); PG8_BAR; PG8_SCHED;
            PG8_LDA(At, 0, 1); PG8_STAGE(PG8_SB(0, 0), b2, voffB); PG8_STAGE(PG8_SB(0, 1), b2 + hstepB, voffB); PG8_STAGE(PG8_SA(0, 0), a2, voffA);
            PG8_WAIT_V(8); PG8_WAIT_L(0); PG8_BAR; if (lo_) PG8_MMA(1, 0, At, B0); if (hi_) PG8_MMA(1, 1, At, B1); PG8_BAR; PG8_SCHED;
            PG8_LDB(B0, 1, 0); PG8_LDB(B1, 1, 1); PG8_SCHED; PG8_LDA(At, 1, 0); PG8_STAGE(PG8_SA(0, 1), a2 + hstepA, voffA);
            PG8_WAIT_V(8); PG8_WAIT_L(0); PG8_BAR; if (lo_) PG8_MMA(0, 0, At, B0); if (hi_) PG8_MMA(0, 1, At, B1); PG8_BAR; PG8_SCHED;
            PG8_LDA(At, 1, 1); PG8_STAGE(PG8_SB(1, 0), b3, voffB); PG8_STAGE(PG8_SB(1, 1), b3 + hstepB, voffB); PG8_STAGE(PG8_SA(1, 0), a3, voffA);
            PG8_WAIT_V(8); PG8_WAIT_L(0); PG8_BAR; if (lo_) PG8_MMA(1, 0, At, B0); if (hi_) PG8_MMA(1, 1, At, B1); PG8_BAR; PG8_SCHED;
        }
        if (wr == 0) PG8_BAR;
        E(acc, cur, wr, wc, fr, fq);
        if (!has_next) break;
#pragma unroll
        for (int a = 0; a < 2; ++a)
#pragma unroll
            for (int b = 0; b < 2; ++b)
#pragma unroll
                for (int m = 0; m < 4; ++m)
#pragma unroll
                    for (int n = 0; n < 2; ++n) acc[a][b][m][n] = (f32x4){0.f, 0.f, 0.f, 0.f};
        cur = nxt; cA = nA; cB = nB; ++ui;
        if (wr == 1) PG8_BAR;
    }
    PG8_WAIT_V(0);
    PG8_BAR;
#undef PG8_SA
#undef PG8_SB
#undef PG8_STAGE
#undef PG8_LDA
#undef PG8_LDB
#undef PG8_MMA
#undef PG8_WAIT_V
#undef PG8_WAIT_L
#undef PG8_BAR
#undef PG8_SCHED
}
}

using pg8::bf16_t; using pg8::bf16x8; using pg8::f32x4; using pg8::u32x4; using pg8::cvt_pk_bf16;
typedef short s16x4 __attribute__((ext_vector_type(4)));
__device__ __forceinline__ f32x4 mfma16(bf16x8 a, bf16x8 b, f32x4 c) { const f32x4 r = __builtin_amdgcn_mfma_f32_16x16x32_bf16(a, b, c, 0, 0, 0); asm volatile("" :: "v"(a), "v"(b)); return r; }
#define LAS __attribute__((address_space(3)))

constexpr int NB = 4, T = 8192, D = 2048, M = NB * T;
constexpr int NP = 15872;
constexpr float LN_EPS = 1e-5f;
constexpr float ALPHA = 1.189207115002721f;
constexpr size_t MiB = 1u << 20;
constexpr size_t WS_CTL = 0;
constexpr size_t WS_BT = 1 * MiB;
constexpr size_t WS_WIN = 2 * MiB;
constexpr size_t WS_WUV = 64 * MiB;
constexpr size_t WS_WA = 66 * MiB, WS_WB = 74 * MiB, WS_WO = 82 * MiB;
constexpr size_t WS_WGA = 90 * MiB, WS_WGX = 90 * MiB + 512 * 1024;
constexpr size_t WS_QL = 96 * MiB;
constexpr size_t WS_CKV = 352 * MiB;
constexpr size_t WS_AG = 368 * MiB;
constexpr size_t WS_QI = 496 * MiB;
constexpr size_t WS_KI = 560 * MiB;
constexpr size_t WS_WI = 564 * MiB;
constexpr size_t WS_XR = 568 * MiB;
constexpr size_t WS_RG = 696 * MiB;
constexpr size_t WS_GB = 824 * MiB;
constexpr size_t WS_CKVF = 952 * MiB;
constexpr size_t WS_END = 984 * MiB;
constexpr int LDS_BYTES = 151552;

__device__ __forceinline__ float shfl_xor_safe(float v, int m) { float r = __shfl_xor(v, m); asm volatile("s_waitcnt lgkmcnt(0)" : "+v"(r)); return r; }
__device__ __forceinline__ void lgkm_fence4(float& a, float& b, float& c, float& d) { asm volatile("s_waitcnt lgkmcnt(0)" : "+v"(a), "+v"(b), "+v"(c), "+v"(d)); }
template <int CTRL> __device__ __forceinline__ float dpp_f(float v) { return __builtin_bit_cast(float, __builtin_amdgcn_update_dpp(0, __builtin_bit_cast(int, v), CTRL, 0xf, 0xf, true)); }
__device__ __forceinline__ float row16_sum(float v) { v += dpp_f<0x121>(v); v += dpp_f<0x122>(v); v += dpp_f<0x124>(v); v += dpp_f<0x128>(v); return v; }
__device__ __forceinline__ float row16_max(float v) { v = fmaxf(v, dpp_f<0x121>(v)); v = fmaxf(v, dpp_f<0x122>(v)); v = fmaxf(v, dpp_f<0x124>(v)); v = fmaxf(v, dpp_f<0x128>(v)); return v; }
__device__ __forceinline__ float rows4_sum(float v) {
    float a = v, b = v;
    asm("s_nop 1\n\tv_permlane32_swap_b32 %0, %1" : "+v"(a), "+v"(b));
    float s = a + b, t = s;
    asm("s_nop 1\n\tv_permlane16_swap_b32 %0, %1" : "+v"(s), "+v"(t));
    return s + t; }
template <int CTRL> __device__ __forceinline__ unsigned dpp_u(unsigned v) { return (unsigned)__builtin_amdgcn_update_dpp(0, (int)v, CTRL, 0xf, 0xf, true); }
__device__ __forceinline__ unsigned wave_incl_scan(unsigned v, int lane) {
    v += dpp_u<0x111>(v); v += dpp_u<0x112>(v); v += dpp_u<0x114>(v); v += dpp_u<0x118>(v);
    const unsigned r0 = (unsigned)__builtin_amdgcn_readlane((int)v, 15), r1 = (unsigned)__builtin_amdgcn_readlane((int)v, 31), r2 = (unsigned)__builtin_amdgcn_readlane((int)v, 47);
    const int row = lane >> 4;
    return v + (row >= 1 ? r0 : 0u) + (row >= 2 ? r1 : 0u) + (row >= 3 ? r2 : 0u); }
__device__ __forceinline__ float bf2f(unsigned short u) { return __builtin_bit_cast(float, (unsigned)u << 16); }
__device__ __forceinline__ float bflo(unsigned w) { return __builtin_bit_cast(float, w << 16); }
__device__ __forceinline__ float bfhi(unsigned w) { return __builtin_bit_cast(float, w & 0xffff0000u); }
__device__ __forceinline__ float fsigmoid(float v) { return __builtin_amdgcn_rcpf(1.f + __expf(-v)); }

struct Ptrs {
    const float *x, *w_in, *kvg, *w_uv, *w_a, *conv_w, *conv_b, *wga, *bga, *wgx, *bgx, *lam, *w_b, *relb, *w_o, *ln_g, *ln_b;
    float* out; unsigned char* ws;
    bf16_t *WinT, *WuvT, *WaT, *WbT, *WoT, *WgaT, *WgxT, *QL, *CKV, *AG, *QI, *KI, *XR, *RG, *GB, *XB, *GA;
    float *WI, *CKVF, *BT;
};

struct EpiProj {
    Ptrs P;
    __device__ __forceinline__ void operator()(const f32x4 (&acc)[2][2][4][2], const pg8::Unit& u, int wr, int wc, int fr, int fq) const {
        const int pn = u.pn; const int row0 = u.pm * 256 + wr * 64 + fr, cl0 = wc * 32 + 8 * fq;
        int kind = 0, ld = 0, coff = 0; bf16_t* dst = nullptr;
        if (pn < 16) { dst = P.QL; ld = 4096; coff = pn * 256; }
        else if (pn == 16) { kind = 3; }
        else if (pn < 25) { dst = P.AG; ld = 2048; coff = (pn - 17) * 256; kind = 1; }
        else if (pn < 29) { dst = P.QI; ld = 1024; coff = (pn - 25) * 256; }
        else if (pn == 29) { kind = 4; }
        else if (pn < 38) { dst = P.XR; ld = 2048; coff = (pn - 30) * 256; }
        else if (pn < 46) { dst = P.RG; ld = 2048; coff = (pn - 38) * 256; kind = 1; }
        else if (pn < 54) { dst = P.GA; ld = 2048; coff = (pn - 46) * 256; kind = 2; }
        else { dst = P.GB; ld = 2048; coff = (pn - 54) * 256; kind = 2; }
#pragma unroll
        for (int ai = 0; ai < 2; ++ai)
#pragma unroll
            for (int m = 0; m < 4; ++m) { const size_t row = (size_t)(row0 + ai * 128 + m * 16);
#pragma unroll
                for (int bj = 0; bj < 2; ++bj) { const int cl = cl0 + bj * 128; f32x4 v0 = acc[ai][bj][m][0], v1 = acc[ai][bj][m][1];
                    if (kind <= 2) {
                        if (kind == 1) {
#pragma unroll
                            for (int e = 0; e < 4; ++e) { v0[e] = v0[e] * fsigmoid(v0[e]); v1[e] = v1[e] * fsigmoid(v1[e]); }
                        } else if (kind == 2) {
#pragma unroll
                            for (int e = 0; e < 4; ++e) { v0[e] = fsigmoid(v0[e]); v1[e] = fsigmoid(v1[e]); }
                        }
                        u32x4 w; w.x = cvt_pk_bf16(v0[0], v0[1]); w.y = cvt_pk_bf16(v0[2], v0[3]); w.z = cvt_pk_bf16(v1[0], v1[1]); w.w = cvt_pk_bf16(v1[2], v1[3]);
                        *(u32x4*)(dst + row * ld + coff + cl) = w;
                    } else if (kind == 3) {
                        float* p = P.CKVF + row * 256 + cl; *(f32x4*)p = v0; *(f32x4*)(p + 4) = v1;
                    } else {
                        if (cl < 64) { u32x4 w; w.x = cvt_pk_bf16(v0[0], v0[1]); w.y = cvt_pk_bf16(v0[2], v0[3]); w.z = cvt_pk_bf16(v1[0], v1[1]); w.w = cvt_pk_bf16(v1[2], v1[3]);
                            *(u32x4*)(P.KI + row * 64 + cl) = w; }
                        else if (cl < 80) { float* p = P.WI + row * 16 + (cl - 64); *(f32x4*)p = v0; *(f32x4*)(p + 4) = v1; }
                    }
                } }
    }
};
template <int MODE> struct EpiGate {
    bf16_t* O; const bf16_t* G;
    __device__ __forceinline__ void operator()(const f32x4 (&acc)[2][2][4][2], const pg8::Unit& u, int wr, int wc, int fr, int fq) const {
        const int row0 = u.pm * 256 + wr * 64 + fr, col0 = u.pn * 256 + wc * 32 + 8 * fq;
#pragma unroll
        for (int ai = 0; ai < 2; ++ai)
#pragma unroll
            for (int m = 0; m < 4; ++m) { const size_t row = (size_t)(row0 + ai * 128 + m * 16);
#pragma unroll
                for (int bj = 0; bj < 2; ++bj) { const size_t off = row * 2048 + col0 + bj * 128; const f32x4 v0 = acc[ai][bj][m][0], v1 = acc[ai][bj][m][1];
                    float r[8];
                    if (MODE == 0) { const u32x4 o = *(const u32x4*)(O + off);
                        r[0] = bflo(o.x) * v0[0]; r[1] = bfhi(o.x) * v0[1]; r[2] = bflo(o.y) * v0[2]; r[3] = bfhi(o.y) * v0[3];
                        r[4] = bflo(o.z) * v1[0]; r[5] = bfhi(o.z) * v1[1]; r[6] = bflo(o.w) * v1[2]; r[7] = bfhi(o.w) * v1[3]; }
                    else { const u32x4 gq = *(const u32x4*)(G + off);
                        r[0] = bflo(gq.x) * v0[0]; r[1] = bfhi(gq.x) * v0[1]; r[2] = bflo(gq.y) * v0[2]; r[3] = bfhi(gq.y) * v0[3];
                        r[4] = bflo(gq.z) * v1[0]; r[5] = bfhi(gq.z) * v1[1]; r[6] = bflo(gq.w) * v1[2]; r[7] = bfhi(gq.w) * v1[3];
                        if (MODE == 2) { const u32x4 o = *(const u32x4*)(O + off);
                            r[0] += bflo(o.x); r[1] += bfhi(o.x); r[2] += bflo(o.y); r[3] += bfhi(o.y); r[4] += bflo(o.z); r[5] += bfhi(o.z); r[6] += bflo(o.w); r[7] += bfhi(o.w); } }
                    u32x4 w; w.x = cvt_pk_bf16(r[0], r[1]); w.y = cvt_pk_bf16(r[2], r[3]); w.z = cvt_pk_bf16(r[4], r[5]); w.w = cvt_pk_bf16(r[6], r[7]);
                    *(u32x4*)(O + off) = w; } }
    }
};
struct EpiOut {
    const float* X; float* Y;
    __device__ __forceinline__ void operator()(const f32x4 (&acc)[2][2][4][2], const pg8::Unit& u, int wr, int wc, int fr, int fq) const {
        const int row0 = u.pm * 256 + wr * 64 + fr, col0 = u.pn * 256 + wc * 32 + 8 * fq;
#pragma unroll
        for (int ai = 0; ai < 2; ++ai)
#pragma unroll
            for (int m = 0; m < 4; ++m) { const size_t row = (size_t)(row0 + ai * 128 + m * 16);
#pragma unroll
                for (int bj = 0; bj < 2; ++bj) { const size_t off = row * 2048 + col0 + bj * 128;
                    const f32x4 x0 = *(const f32x4*)(X + off), x1 = *(const f32x4*)(X + off + 4);
                    *(f32x4*)(Y + off) = x0 * ALPHA + acc[ai][bj][m][0]; *(f32x4*)(Y + off + 4) = x1 * ALPHA + acc[ai][bj][m][1]; } }
    }
};

__device__ __forceinline__ void tr_item(const float* W, int ldw, int k0, int n0, int nv, bf16_t* WT, int ldt, int drow0, int dcol0, float* scr, int lane) {
    float wv[32];
#pragma unroll
    for (int i = 0; i < 32; ++i) { const int kk = 2 * i + (lane >> 5), nn = lane & 31; wv[i] = nn < nv ? W[(size_t)(k0 + kk) * ldw + n0 + nn] : 0.f; }
#pragma unroll
    for (int i = 0; i < 32; ++i) { const int kk = 2 * i + (lane >> 5), nn = lane & 31; scr[kk * 33 + nn] = wv[i]; }
    asm volatile("s_waitcnt lgkmcnt(0)" ::: "memory");
    const int c = lane & 7;
#pragma unroll
    for (int j = 0; j < 4; ++j) { const int n = (lane >> 3) + 8 * j; const float* s = scr + (8 * c) * 33 + n;
        u32x4 o; o.x = cvt_pk_bf16(s[0 * 33], s[1 * 33]); o.y = cvt_pk_bf16(s[2 * 33], s[3 * 33]); o.z = cvt_pk_bf16(s[4 * 33], s[5 * 33]); o.w = cvt_pk_bf16(s[6 * 33], s[7 * 33]);
        if (n < nv) *(u32x4*)(WT + (size_t)(drow0 + n) * ldt + dcol0 + k0 + 8 * c) = o; }
    asm volatile("s_waitcnt lgkmcnt(0)" ::: "memory");
}
__device__ __forceinline__ void p0_prologue(const Ptrs& P, unsigned char* lds, int tid, int G) {
    const int lane = tid & 63, wave = __builtin_amdgcn_readfirstlane(tid >> 6);
    float* scr = (float*)(lds + wave * 8448);
    const int gw = blockIdx.x * 8 + wave, NGW = G * 8;
    for (int it = gw; it < 491 * 32; it += NGW) { const int ci = it >> 5, kb = it & 31; int n0, nv = 32, dr;
        if (ci < 234) { n0 = 32 * ci; dr = n0; } else if (ci == 234) { n0 = 7488; nv = 16; dr = n0; } else { n0 = 7504 + 32 * (ci - 235); dr = n0 + 176; }
        tr_item(P.w_in, 15696, 64 * kb, n0, nv, P.WinT, 2048, dr, 0, scr, lane); }
    for (int it = gw; it < 2048; it += NGW) { const int kb = it >> 6, nb = it & 63; tr_item(P.w_a, 2048, 64 * kb, 32 * nb, 32, P.WaT, 2048, 32 * nb, 0, scr, lane); }
    for (int it = gw; it < 2048; it += NGW) { const int kb = it >> 6, nb = it & 63; tr_item(P.w_b, 2048, 64 * kb, 32 * nb, 32, P.WbT, 2048, 32 * nb, 0, scr, lane); }
    for (int it = gw; it < 2048; it += NGW) { const int kb = it >> 6, nb = it & 63; tr_item(P.w_o, 2048, 64 * kb, 32 * nb, 32, P.WoT, 2048, 32 * nb, 0, scr, lane); }
    for (int it = gw; it < 256; it += NGW) { const int h = it >> 4, kb = (it >> 2) & 3, nb = it & 3;
        tr_item(P.w_uv + (size_t)h * 32768, 128, 64 * kb, 32 * nb, 32, P.WuvT, 512, h * 128 + 32 * nb, (h & 1) * 256, scr, lane); }
    for (int it = gw; it < 128; it += NGW) { const int n = (it >> 3) & 15, kb = (it >> 2) & 1, nb = it & 3;
        tr_item(P.wga + (size_t)n * 16384, 128, 64 * kb, 32 * nb, 32, P.WgaT, 128, n * 128 + 32 * nb, 0, scr, lane); }
    for (int it = gw; it < 128; it += NGW) { const int n = (it >> 3) & 15, kb = (it >> 2) & 1, nb = it & 3;
        tr_item(P.wgx + (size_t)n * 16384, 128, 64 * kb, 32 * nb, 32, P.WgxT, 128, n * 128 + 32 * nb, 0, scr, lane); }
    const size_t gt = (size_t)blockIdx.x * 512 + tid, GT = (size_t)G * 512;
    const u32x4 z = {0u, 0u, 0u, 0u};
    for (size_t i = gt; i < 176 * 256; i += GT) *(u32x4*)(P.WinT + (size_t)7504 * 2048 + i * 8) = z;
    for (size_t i = gt; i < 2048 * 32; i += GT) { const size_t r = i >> 5, c = i & 31; *(u32x4*)(P.WuvT + r * 512 + ((((r >> 7) & 1) ^ 1) * 256) + c * 8) = z; }
#pragma unroll 4
    for (size_t i = gt; i < (size_t)M * D / 8; i += GT) { const f32x4 a = *(const f32x4*)(P.x + i * 8), b = *(const f32x4*)(P.x + i * 8 + 4);
        u32x4 w; w.x = cvt_pk_bf16(a[0], a[1]); w.y = cvt_pk_bf16(a[2], a[3]); w.z = cvt_pk_bf16(b[0], b[1]); w.w = cvt_pk_bf16(b[2], b[3]); *(u32x4*)(P.XB + i * 8) = w; }
    for (size_t i = gt; i < 129 * 16; i += GT) { const int n = (int)(i >> 4), h = (int)(i & 15); int bk;
        if (n < 16) bk = n; else { bk = 16 + (int)(logf((float)n / 16.f) / 2.0794415416798357f * 16.f); bk = bk > 31 ? 31 : bk; }
        P.BT[i] = P.relb[bk * 16 + h]; }
}

__device__ __forceinline__ void ckv_norm_rows(const Ptrs& P, int row0, int nrows, int tid) {
    const int lane = tid & 63, wave = tid >> 6;
    const f32x4 gq = *(const f32x4*)(P.kvg + 4 * lane);
    for (int r0 = wave; r0 < nrows; r0 += 64) {
        f32x4 v[8];
#pragma unroll
        for (int k = 0; k < 8; ++k) { const int r = r0 + 8 * k; v[k] = *(const f32x4*)(P.CKVF + ((size_t)row0 + (r < nrows ? r : r0)) * 256 + 4 * lane); }
#pragma unroll
        for (int k = 0; k < 8; ++k) { const int r = r0 + 8 * k;
            float s = v[k][0] * v[k][0] + v[k][1] * v[k][1] + v[k][2] * v[k][2] + v[k][3] * v[k][3];
            s = rows4_sum(row16_sum(s));
            const float rs = 1.f / sqrtf(s * (1.f / 256.f) + LN_EPS);
            uint2 w; w.x = cvt_pk_bf16(v[k][0] * rs * gq[0], v[k][1] * rs * gq[1]); w.y = cvt_pk_bf16(v[k][2] * rs * gq[2], v[k][3] * rs * gq[3]);
            if (r < nrows) *(uint2*)(P.CKV + ((size_t)row0 + r) * 256 + 4 * lane) = w; }
    }
}

__device__ __forceinline__ float em1_poly(float x) { return x * (1.f + x * (0.5f + x * (0.16666667f + x * (0.041666668f + x * (0.0083333338f + x * 0.0013888889f))))); }
#define BAR_LDS() asm volatile("s_waitcnt lgkmcnt(0)\n\ts_barrier" ::: "memory")
__device__ __forceinline__ void rglru_item(const Ptrs& P, unsigned char* lds, int b, int n, int tid) {
    const int lane = tid & 63, w = __builtin_amdgcn_readfirstlane(tid >> 6), g = lane >> 4, r16 = lane & 15;
    bf16_t* XCb = (bf16_t*)lds;
    float* XCf = (float*)(lds + 17408);
    float* LA = (float*)(lds + 17408 + 32768);
    float* LB = LA + 8192;
    const size_t rowb = (size_t)b * T;
    const int ce = 16 * w + r16, ch = n * 128 + ce;
    bf16x8 Ba[4], Bx[4];
#pragma unroll
    for (int ks = 0; ks < 4; ++ks) { Ba[ks] = *(const bf16x8*)(P.WgaT + (size_t)ch * 128 + 32 * ks + 8 * g); Bx[ks] = *(const bf16x8*)(P.WgxT + (size_t)ch * 128 + 32 * ks + 8 * g); }
    const float ba = P.bga[ch], bx = P.bgx[ch];
    const float sp8 = 8.f * log1pf(expf(-P.lam[ch]));
    const bool big = __any(sp8 > 0.14f);
    float h = 0.f;
    const int tt = tid >> 3, c0 = (tid & 7) * 16, cg0 = n * 128 + c0;
    u32x4 xr[4][2];
#define RG_LOAD(T0) do { _Pragma("unroll") for (int k = 0; k < 4; ++k) { int tk = (T0) + tt - 3 + k; tk = tk < 0 ? 0 : tk; const bf16_t* xp = P.XR + (rowb + tk) * 2048 + cg0; \
            xr[k][0] = *(const u32x4*)xp; xr[k][1] = *(const u32x4*)(xp + 8); } } while (0)
    RG_LOAD(0);
    for (int chunk = 0; chunk < T / 64; ++chunk) {
        const int t0 = chunk * 64;
        u32x4 gc0, gc1;
        {
            float xc[16];
#pragma unroll
            for (int e = 0; e < 16; e += 4) { const f32x4 v = *(const f32x4*)(P.conv_b + cg0 + e); xc[e] = v[0]; xc[e + 1] = v[1]; xc[e + 2] = v[2]; xc[e + 3] = v[3]; }
#pragma unroll
            for (int k = 0; k < 4; ++k) { const float m = (t0 + tt - 3 + k) >= 0 ? 1.f : 0.f;
                float cwk[16];
#pragma unroll
                for (int e = 0; e < 16; e += 4) { const f32x4 c = *(const f32x4*)(P.conv_w + k * 2048 + cg0 + e); cwk[e] = c[0]; cwk[e + 1] = c[1]; cwk[e + 2] = c[2]; cwk[e + 3] = c[3]; }
                const u32x4 xa = xr[k][0], xb2 = xr[k][1];
                const float xv[16] = {bflo(xa.x), bfhi(xa.x), bflo(xa.y), bfhi(xa.y), bflo(xa.z), bfhi(xa.z), bflo(xa.w), bfhi(xa.w),
                                      bflo(xb2.x), bfhi(xb2.x), bflo(xb2.y), bfhi(xb2.y), bflo(xb2.z), bfhi(xb2.z), bflo(xb2.w), bfhi(xb2.w)};
#pragma unroll
                for (int e = 0; e < 16; ++e) xc[e] += (cwk[e] * m) * xv[e]; }
#pragma unroll
            for (int e = 0; e < 16; e += 4) *(f32x4*)(XCf + tt * 128 + c0 + e) = (f32x4){xc[e], xc[e + 1], xc[e + 2], xc[e + 3]};
            u32x4 w0, w1; w0.x = cvt_pk_bf16(xc[0], xc[1]); w0.y = cvt_pk_bf16(xc[2], xc[3]); w0.z = cvt_pk_bf16(xc[4], xc[5]); w0.w = cvt_pk_bf16(xc[6], xc[7]);
            w1.x = cvt_pk_bf16(xc[8], xc[9]); w1.y = cvt_pk_bf16(xc[10], xc[11]); w1.z = cvt_pk_bf16(xc[12], xc[13]); w1.w = cvt_pk_bf16(xc[14], xc[15]);
            *(u32x4*)(XCb + tt * 136 + c0) = w0; *(u32x4*)(XCb + tt * 136 + c0 + 8) = w1;
            { const bf16_t* gp_ = P.RG + (rowb + t0 + tt) * 2048 + cg0; gc0 = *(const u32x4*)gp_; gc1 = *(const u32x4*)(gp_ + 8); }
            if (chunk + 1 < T / 64) RG_LOAD(t0 + 64);
        }
        BAR_LDS();
#pragma unroll
        for (int mt = 0; mt < 4; ++mt) {
            f32x4 ar = {0.f, 0.f, 0.f, 0.f}, ai = {0.f, 0.f, 0.f, 0.f};
#pragma unroll
            for (int ks = 0; ks < 4; ++ks) { const bf16x8 A = *(const bf16x8*)(XCb + (16 * mt + r16) * 136 + 32 * ks + 8 * g);
                ar = mfma16(A, Ba[ks], ar); ai = mfma16(A, Bx[ks], ai); }
#pragma unroll
            for (int j = 0; j < 4; ++j) { const int tok = 16 * mt + 4 * g + j;
                const float r = fsigmoid(ar[j] + ba), ig = fsigmoid(ai[j] + bx);
                const float la = -sp8 * r;
                float a, m2;
                if (big) { a = __expf(la); m2 = 1.f - __expf(2.f * la); } else { a = 1.f + em1_poly(la); m2 = -em1_poly(2.f * la); }
                float mult = sqrtf(fmaxf(m2, 0.f)); if (t0 + tok == 0) mult = 1.f;
                LA[tok * 128 + ce] = a; LB[tok * 128 + ce] = mult * ig * XCf[tok * 128 + ce]; }
        }
        BAR_LDS();
        if (tid < 128) {
#pragma unroll 1
            for (int t16 = 0; t16 < 64; t16 += 16) { float av[16], bv[16];
#pragma unroll
                for (int e = 0; e < 16; ++e) { av[e] = LA[(t16 + e) * 128 + tid]; bv[e] = LB[(t16 + e) * 128 + tid]; }
#pragma unroll
                for (int e = 0; e < 16; ++e) { h = av[e] * h + bv[e]; LB[(t16 + e) * 128 + tid] = h; } }
        }
        BAR_LDS();
        {
            bf16_t* gp = P.RG + (rowb + t0 + tt) * 2048 + cg0;
            const float* hp = LB + tt * 128 + c0;
            u32x4 o0, o1;
            o0.x = cvt_pk_bf16(hp[0] * bflo(gc0.x), hp[1] * bfhi(gc0.x)); o0.y = cvt_pk_bf16(hp[2] * bflo(gc0.y), hp[3] * bfhi(gc0.y));
            o0.z = cvt_pk_bf16(hp[4] * bflo(gc0.z), hp[5] * bfhi(gc0.z)); o0.w = cvt_pk_bf16(hp[6] * bflo(gc0.w), hp[7] * bfhi(gc0.w));
            o1.x = cvt_pk_bf16(hp[8] * bflo(gc1.x), hp[9] * bfhi(gc1.x)); o1.y = cvt_pk_bf16(hp[10] * bflo(gc1.y), hp[11] * bfhi(gc1.y));
            o1.z = cvt_pk_bf16(hp[12] * bflo(gc1.z), hp[13] * bfhi(gc1.z)); o1.w = cvt_pk_bf16(hp[14] * bflo(gc1.w), hp[15] * bfhi(gc1.w));
            *(u32x4*)gp = o0; *(u32x4*)(gp + 8) = o1;
        }
    }
#undef RG_LOAD
    __syncthreads();
}

__device__ __forceinline__ unsigned f2key(float f) { const unsigned u = __builtin_bit_cast(unsigned, f); return (u & 0x80000000u) ? ~u : (u | 0x80000000u); }
__device__ __forceinline__ unsigned mbcnt64(unsigned long long m) { return __builtin_amdgcn_mbcnt_hi((unsigned)(m >> 32), __builtin_amdgcn_mbcnt_lo((unsigned)m, 0u)); }
__device__ __forceinline__ bf16x8 tr_read2(unsigned a0, unsigned a1) {
    s16x4 r0, r1;
    asm volatile("ds_read_b64_tr_b16 %0, %2\n\tds_read_b64_tr_b16 %1, %3\n\ts_waitcnt lgkmcnt(0)" : "=&v"(r0), "=&v"(r1) : "v"(a0), "v"(a1) : "memory");
    bf16x8 r; r[0] = r0[0]; r[1] = r0[1]; r[2] = r0[2]; r[3] = r0[3]; r[4] = r1[0]; r[5] = r1[1]; r[6] = r1[2]; r[7] = r1[3]; return r;
}
__device__ __forceinline__ void attn_item(const Ptrs& P, unsigned char* lds, int b, int tq0, int tid) {
    const int lane = tid & 63, w = __builtin_amdgcn_readfirstlane(tid >> 6), g = lane >> 4, r16 = lane & 15;
    constexpr int SP = 264;
    bf16_t* stg = (bf16_t*)lds;
    unsigned char* l2 = lds + 135168;
    unsigned short* sel = (unsigned short*)l2;
    unsigned* cntw = (unsigned*)(l2 + 2048);
    unsigned* gte = (unsigned*)(l2 + 2048 + 256);
    bf16_t* Pm = (bf16_t*)(l2 + 4096);
    const size_t rowb = (size_t)b * T;
    const int tmax = tq0 + 3;
    if (tmax < 256 || (DBG & 4)) {
        for (int i = tid; i < 1024; i += 512) sel[i] = (unsigned short)(((i & 255) <= tq0 + (i >> 8)) ? (i & 255) : 0);
        __syncthreads();
    } else {
        bf16x8 Aq[4][2]; f32x4 wq[4];
#pragma unroll
        for (int q = 0; q < 4; ++q) { const bf16_t* qp = P.QI + (rowb + tq0 + q) * 1024 + r16 * 64 + 8 * g; Aq[q][0] = *(const bf16x8*)qp; Aq[q][1] = *(const bf16x8*)(qp + 32);
            wq[q] = *(const f32x4*)(P.WI + (rowb + tq0 + q) * 16 + 4 * g); }
        unsigned* KB = (unsigned*)lds;
        const int nch = (tmax >> 6) + 1;
        const int ni = (w < nch) ? ((nch - w + 7) >> 3) : 0;
        bf16x8 Bk[4][2];
#define TILE_LOAD(SLOT, CC, TT) do { const bf16_t* kp = P.KI + (rowb + 64 * (CC) + 16 * (TT) + r16) * 64 + 8 * g; Bk[SLOT][0] = *(const bf16x8*)kp; Bk[SLOT][1] = *(const bf16x8*)(kp + 32); } while (0)
#define TILE_MATH(SLOT, TT) do { _Pragma("unroll") for (int q = 0; q < 4; ++q) { f32x4 a = {0.f, 0.f, 0.f, 0.f}; \
            a = mfma16(Aq[q][0], Bk[SLOT][0], a); a = mfma16(Aq[q][1], Bk[SLOT][1], a); \
            pv[q][TT] = wq[q][0] * fmaxf(a[0], 0.f) + wq[q][1] * fmaxf(a[1], 0.f) + wq[q][2] * fmaxf(a[2], 0.f) + wq[q][3] * fmaxf(a[3], 0.f); } } while (0)
        if (ni > 0) { TILE_LOAD(0, w, 0); TILE_LOAD(1, w, 1); }
#pragma unroll 1
        for (int it = 0; it < ni; ++it) {
            const int c = 8 * it + w; const bool more = it + 1 < ni;
            float pv[4][4], sv[4];
            TILE_LOAD(2, c, 2); TILE_MATH(0, 0);
            TILE_LOAD(3, c, 3); TILE_MATH(1, 1);
            if (more) TILE_LOAD(0, c + 8, 0);
            TILE_MATH(2, 2);
            if (more) TILE_LOAD(1, c + 8, 1);
            TILE_MATH(3, 3);
#pragma unroll
            for (int q = 0; q < 4; ++q) { float a0 = pv[q][0], b0 = pv[q][2], a1 = pv[q][1], b1 = pv[q][3];
                asm("s_nop 1\n\tv_permlane32_swap_b32 %0, %1" : "+v"(a0), "+v"(b0));
                asm("s_nop 1\n\tv_permlane32_swap_b32 %0, %1" : "+v"(a1), "+v"(b1));
                float x = a0 + b0, y = a1 + b1;
                asm("s_nop 1\n\tv_permlane16_swap_b32 %0, %1" : "+v"(x), "+v"(y));
                sv[q] = x + y; }
            const int s = 64 * c + lane;
#pragma unroll
            for (int q = 0; q < 4; ++q) KB[q * 8192 + s] = (s <= tq0 + q) ? f2key(sv[q]) : 0u;
        }
#undef TILE_LOAD
#undef TILE_MATH
        __syncthreads();
        const int qs = w >> 1, hs = w & 1;
        unsigned k2[64];
#pragma unroll
        for (int r = 0; r < 64; ++r) k2[r] = KB[qs * 8192 + 64 * (2 * r + hs) + lane];
        __syncthreads();
#pragma unroll
        for (int r = 0; r < 64; ++r) k2[r] = (2 * r + hs < nch) ? k2[r] : 0u;
        const int nact = (nch + 1 - hs) >> 1;
        volatile unsigned* xw = (volatile unsigned*)(lds + 147456);
        const unsigned seq = (xw[32 + w] + 1u) & 0xffu; if (lane == 0) xw[32 + w] = seq;
#define PAIR_XCHG(SLOT, TAG, MINE, OTHER) do { const unsigned tg_ = (seq << 8) | (unsigned)(TAG); if (lane == 0) xw[w * 4 + (SLOT)] = ((MINE) << 16) | tg_; \
            unsigned v_; do { v_ = xw[(w ^ 1) * 4 + (SLOT)]; } while ((v_ & 0xffffu) != tg_); OTHER = v_ >> 16; } while (0)
        unsigned th = 0u;
        for (int bit = 31; bit >= 0; --bit) {
            const unsigned cand = th | (1u << bit); unsigned cnt = 0, oth;
#pragma unroll
            for (int k = 0; k < 4; ++k) if (16 * k < nact) {
#pragma unroll
                for (int r = 16 * k; r < 16 * k + 16; ++r) cnt += (unsigned)__popcll(__ballot(k2[r] >= cand)); }
            PAIR_XCHG(bit & 1, 1 + bit, cnt, oth);
            cnt += oth;
            if (cnt >= 256u) th = cand;
            if (cnt == 256u) break;
        }
        unsigned cg = 0, ce = 0;
#pragma unroll
        for (int k = 0; k < 4; ++k) if (16 * k < nact) {
#pragma unroll
            for (int r = 16 * k; r < 16 * k + 16; ++r) { cg += (k2[r] > th) ? 1u : 0u; ce += (k2[r] == th) ? 1u : 0u; } }
        const unsigned ig = wave_incl_scan(cg, lane), ie = wave_incl_scan(ce, lane);
        const unsigned ngt = (unsigned)__builtin_amdgcn_readlane((int)ig, 63), neq = (unsigned)__builtin_amdgcn_readlane((int)ie, 63);
        unsigned ogt, oeq;
        PAIR_XCHG(2, 40, ngt, ogt); PAIR_XCHG(3, 41, neq, oeq);
        const unsigned tot_gt = ngt + ogt, quota = 256u - tot_gt;
        unsigned pos_g = (hs ? ogt : 0u) + ig - cg, pos_e = (hs ? oeq : 0u) + ie - ce;
        const bool any_eq = (neq + oeq) != 0u;
#pragma unroll
        for (int k = 0; k < 4; ++k) if (16 * k < nact) {
#pragma unroll
            for (int r = 16 * k; r < 16 * k + 16; ++r) { const unsigned short idx = (unsigned short)(64 * (2 * r + hs) + lane);
                if (k2[r] > th) { sel[qs * 256 + pos_g] = idx; ++pos_g; }
                if (any_eq) { if (k2[r] == th) { if (pos_e < quota) sel[qs * 256 + tot_gt + pos_e] = idx; ++pos_e; } } } }
        { unsigned dn_; PAIR_XCHG(0, 42, 0u, dn_); (void)dn_; }
#undef PAIR_XCHG
    }
    const int q = w >> 1, half = w & 1, tq = tq0 + q;
    const int nsel = tq + 1 < 256 ? tq + 1 : 256;
    bf16x8 Af[8];
    {
        const bf16_t* qlp = P.QL + (rowb + tq) * 4096 + r16 * 256 + 8 * g;
#pragma unroll
        for (int ks = 0; ks < 8; ++ks) Af[ks] = *(const bf16x8*)(qlp + 32 * ks);
    }
    bf16_t* stw = stg + w * 32 * SP;
    bf16_t* Pw = (bf16_t*)(l2 + 2048) + w * 16 * 40;
    volatile unsigned* xa = (volatile unsigned*)(lds + 147456);
    const unsigned aseq = (xa[40 + w] + 1u) & 0xffffu; if (lane == 0) xa[40 + w] = aseq;
    float mrun[4], lrun[4];
#pragma unroll
    for (int j = 0; j < 4; ++j) { mrun[j] = -1e30f; lrun[j] = 0.f; }
    f32x4 oacc[16];
#pragma unroll
    for (int dt = 0; dt < 16; ++dt) oacc[dt] = (f32x4){0.f, 0.f, 0.f, 0.f};
    const int qq = r16 >> 2, pp4 = lane & 3;
    const unsigned tr_base = (unsigned)(uintptr_t)stw + (unsigned)(((8 * g + qq) * SP + 4 * pp4) * 2);
    const int slot0 = 128 * half;
#define STG_LOAD(CK) do { _Pragma("unroll") for (int it = 0; it < 16; ++it) { const int pp = it * 64 + lane, kk = pp >> 5, cp = pp & 31; \
        const int idx = (int)sel[q * 256 + slot0 + 32 * (CK) + kk]; stv[it] = *(const u32x4*)(P.CKV + (rowb + idx) * 256 + 8 * cp); } } while (0)
#define TR8(R, OFF) asm volatile( \
            "ds_read_b64_tr_b16 %0, %8 offset:" #OFF "+0\n\tds_read_b64_tr_b16 %1, %8 offset:" #OFF "+2112\n\t" \
            "ds_read_b64_tr_b16 %2, %8 offset:" #OFF "+32\n\tds_read_b64_tr_b16 %3, %8 offset:" #OFF "+2144\n\t" \
            "ds_read_b64_tr_b16 %4, %8 offset:" #OFF "+64\n\tds_read_b64_tr_b16 %5, %8 offset:" #OFF "+2176\n\t" \
            "ds_read_b64_tr_b16 %6, %8 offset:" #OFF "+96\n\tds_read_b64_tr_b16 %7, %8 offset:" #OFF "+2208\n\t" \
            "s_waitcnt lgkmcnt(0)" \
            : "=&v"(R[0]), "=&v"(R[1]), "=&v"(R[2]), "=&v"(R[3]), "=&v"(R[4]), "=&v"(R[5]), "=&v"(R[6]), "=&v"(R[7]) \
            : "v"(tr_base) : "memory")
    u32x4 stv[16];
    STG_LOAD(0);
#pragma unroll 1
    for (int ck = 0; ck < 4; ++ck) {
#pragma unroll
        for (int it = 0; it < 16; ++it) { const int pp = it * 64 + lane, kk = pp >> 5, cp = pp & 31; *(u32x4*)(stw + kk * SP + 8 * cp) = stv[it]; }
        if (ck < 3) STG_LOAD(ck + 1);
        asm volatile("s_waitcnt lgkmcnt(0)" ::: "memory");
        f32x4 sc[2];
#pragma unroll
        for (int k2 = 0; k2 < 2; ++k2) {
            const int slot = slot0 + 32 * ck + 16 * k2 + r16; const bool valid = slot < nsel; const int idx = (int)sel[q * 256 + slot];
            int dist = tq - idx; dist = dist > 128 ? 128 : dist; dist = dist < 0 ? 0 : dist;
            const f32x4 bb = *(const f32x4*)(P.BT + dist * 16 + 4 * g);
            const bf16_t* kp = stw + (16 * k2 + r16) * SP + 8 * g;
            f32x4 a = {0.f, 0.f, 0.f, 0.f};
#pragma unroll
            for (int ks = 0; ks < 8; ++ks) a = mfma16(Af[ks], *(const bf16x8*)(kp + 32 * ks), a);
#pragma unroll
            for (int j = 0; j < 4; ++j) a[j] = valid ? a[j] * 0.0625f + bb[j] : -1e30f;
            sc[k2] = a;
        }
#pragma unroll
        for (int j = 0; j < 4; ++j) {
            const float mn = fmaxf(mrun[j], row16_max(fmaxf(sc[0][j], sc[1][j])));
            const float scale = __expf(mrun[j] - mn);
            const float p0 = __expf(sc[0][j] - mn), p1 = __expf(sc[1][j] - mn);
            lrun[j] = lrun[j] * scale + row16_sum(p0 + p1);
            mrun[j] = mn;
#pragma unroll
            for (int dt = 0; dt < 16; ++dt) oacc[dt][j] *= scale;
            Pw[(4 * g + j) * 40 + r16] = (bf16_t)(cvt_pk_bf16(p0, 0.f) & 0xffffu);
            Pw[(4 * g + j) * 40 + 16 + r16] = (bf16_t)(cvt_pk_bf16(p1, 0.f) & 0xffffu);
        }
        asm volatile("s_waitcnt lgkmcnt(0)" ::: "memory");
        const bf16x8 Ap = *(const bf16x8*)(Pw + r16 * 40 + 8 * g);
#pragma unroll
        for (int hh = 0; hh < 4; ++hh) {
            s16x4 r[8];
            if (hh == 0) TR8(r, 0); else if (hh == 1) TR8(r, 128); else if (hh == 2) TR8(r, 256); else TR8(r, 384);
#pragma unroll
            for (int dt = 0; dt < 4; ++dt) { bf16x8 Bv; Bv[0] = r[2 * dt][0]; Bv[1] = r[2 * dt][1]; Bv[2] = r[2 * dt][2]; Bv[3] = r[2 * dt][3];
                Bv[4] = r[2 * dt + 1][0]; Bv[5] = r[2 * dt + 1][1]; Bv[6] = r[2 * dt + 1][2]; Bv[7] = r[2 * dt + 1][3];
                oacc[4 * hh + dt] = mfma16(Ap, Bv, oacc[4 * hh + dt]); }
        }
    }
#undef STG_LOAD
#undef TR8
    {
        float* cmb = (float*)stw;
#pragma unroll
        for (int dt = 0; dt < 8; ++dt)
#pragma unroll
            for (int j = 0; j < 4; ++j) cmb[(dt * 4 + j) * 64 + lane] = half ? oacc[dt][j] : oacc[8 + dt][j];
#pragma unroll
        for (int j = 0; j < 4; ++j) { cmb[2048 + j * 64 + lane] = mrun[j]; cmb[2304 + j * 64 + lane] = lrun[j]; }
        asm volatile("s_waitcnt lgkmcnt(0)" ::: "memory");
        if (lane == 0) xa[48 + w] = aseq;
        while (xa[48 + (w ^ 1)] != aseq) { }
        const float* pc = (const float*)(stg + (w ^ 1) * 32 * SP);
        float wa[4], wb[4];
#pragma unroll
        for (int j = 0; j < 4; ++j) { const float mo = pc[2048 + j * 64 + lane], lo = pc[2304 + j * 64 + lane];
            const float mm = fmaxf(mrun[j], mo); const float ea = __expf(mrun[j] - mm), eb = __expf(mo - mm);
            const float inv = 1.f / (lrun[j] * ea + lo * eb); wa[j] = ea * inv; wb[j] = eb * inv; }
        bf16_t* op = P.QL + (rowb + tq) * 4096;
#pragma unroll
        for (int dt = 0; dt < 8; ++dt)
#pragma unroll
            for (int j = 0; j < 4; ++j) { const float v = (half ? oacc[8 + dt][j] : oacc[dt][j]) * wa[j] + pc[(dt * 4 + j) * 64 + lane] * wb[j];
                op[(4 * g + j) * 256 + 16 * (8 * half + dt) + r16] = (bf16_t)(cvt_pk_bf16(v, 0.f) & 0xffffu); }
    }
}

__device__ __forceinline__ void ln_rows(const Ptrs& P, int tid, int G) {
    const int lane = tid & 63, gw = blockIdx.x * 8 + (tid >> 6), NGW = G * 8;
    f32x4 gg[8], bb[8];
#pragma unroll
    for (int j = 0; j < 8; ++j) { gg[j] = *(const f32x4*)(P.ln_g + 4 * lane + 256 * j); bb[j] = *(const f32x4*)(P.ln_b + 4 * lane + 256 * j); }
    for (int m = gw; m < M; m += 2 * NGW) {
        const int m1 = m + NGW; const bool two = m1 < M;
        float* y0 = P.out + (size_t)m * D + 4 * lane; float* y1 = P.out + (size_t)(two ? m1 : m) * D + 4 * lane;
        f32x4 v[8], u[8]; float s = 0.f, t = 0.f;
#pragma unroll
        for (int j = 0; j < 8; ++j) { v[j] = *(const f32x4*)(y0 + 256 * j); u[j] = *(const f32x4*)(y1 + 256 * j); }
#pragma unroll
        for (int j = 0; j < 8; ++j) { s += (v[j][0] + v[j][1]) + (v[j][2] + v[j][3]); t += (u[j][0] + u[j][1]) + (u[j][2] + u[j][3]); }
        s = rows4_sum(row16_sum(s)); t = rows4_sum(row16_sum(t));
        const float mean0 = s * (1.f / D), mean1 = t * (1.f / D); float s2 = 0.f, t2 = 0.f;
#pragma unroll
        for (int j = 0; j < 8; ++j) { v[j] = v[j] - mean0; u[j] = u[j] - mean1;
            s2 += (v[j][0] * v[j][0] + v[j][1] * v[j][1]) + (v[j][2] * v[j][2] + v[j][3] * v[j][3]);
            t2 += (u[j][0] * u[j][0] + u[j][1] * u[j][1]) + (u[j][2] * u[j][2] + u[j][3] * u[j][3]); }
        s2 = rows4_sum(row16_sum(s2)); t2 = rows4_sum(row16_sum(t2));
        const float rstd0 = 1.f / sqrtf(s2 * (1.f / D) + LN_EPS), rstd1 = 1.f / sqrtf(t2 * (1.f / D) + LN_EPS);
#pragma unroll
        for (int j = 0; j < 8; ++j) __builtin_nontemporal_store(v[j] * rstd0 * gg[j] + bb[j], (f32x4*)(y0 + 256 * j));
        if (two) {
#pragma unroll
            for (int j = 0; j < 8; ++j) __builtin_nontemporal_store(u[j] * rstd1 * gg[j] + bb[j], (f32x4*)(y1 + 256 * j)); }
    }
}

struct Args { const float* in[17]; float* out; unsigned char* ws; int ph_lo, ph_hi; };
constexpr int NPH = 7;

__global__ void __launch_bounds__(512, 2) mega_fwd(Args args) {
    extern __shared__ __attribute__((aligned(16))) unsigned char lds[];
    cg::grid_group grid = cg::this_grid();
    const int tid = threadIdx.x, G = gridDim.x;
    Ptrs P;
    P.x = args.in[0]; P.w_in = args.in[1]; P.kvg = args.in[2]; P.w_uv = args.in[3]; P.w_a = args.in[4]; P.conv_w = args.in[5]; P.conv_b = args.in[6];
    P.wga = args.in[7]; P.bga = args.in[8]; P.wgx = args.in[9]; P.bgx = args.in[10]; P.lam = args.in[11]; P.w_b = args.in[12]; P.relb = args.in[13];
    P.w_o = args.in[14]; P.ln_g = args.in[15]; P.ln_b = args.in[16]; P.out = args.out; P.ws = args.ws;
    unsigned char* ws = args.ws;
    P.WinT = (bf16_t*)(ws + WS_WIN); P.WuvT = (bf16_t*)(ws + WS_WUV); P.WaT = (bf16_t*)(ws + WS_WA); P.WbT = (bf16_t*)(ws + WS_WB); P.WoT = (bf16_t*)(ws + WS_WO);
    P.WgaT = (bf16_t*)(ws + WS_WGA); P.WgxT = (bf16_t*)(ws + WS_WGX); P.QL = (bf16_t*)(ws + WS_QL); P.CKV = (bf16_t*)(ws + WS_CKV); P.AG = (bf16_t*)(ws + WS_AG);
    P.QI = (bf16_t*)(ws + WS_QI); P.KI = (bf16_t*)(ws + WS_KI); P.XR = (bf16_t*)(ws + WS_XR); P.RG = (bf16_t*)(ws + WS_RG); P.GB = (bf16_t*)(ws + WS_GB);
    P.XB = (bf16_t*)args.out; P.GA = (bf16_t*)args.out + (size_t)M * D;
    P.WI = (float*)(ws + WS_WI); P.CKVF = (float*)(ws + WS_CKVF); P.BT = (float*)(ws + WS_BT);
    unsigned* ctl = (unsigned*)(ws + WS_CTL);
    PG8_LAS unsigned char* ldsl = (PG8_LAS unsigned char*)lds;
    const int lo = args.ph_lo, hi = args.ph_hi;
#define IN(k) (lo <= (k) && (k) < hi)
#define SEAM(k) do { if (IN(k) && IN((k) + 1)) grid.sync(); } while (0)

    if (IN(0)) { if (blockIdx.x == 0 && tid < 4) ctl[64 * tid] = 0u; p0_prologue(P, lds, tid, G); }
    SEAM(0);
    if (IN(1)) {
        pg8::Gemm g{P.XB, P.WinT, 2048, 2048, 2048, 0}; pg8::StaticOrder S; S.init(M, NP, G, (int)blockIdx.x);
        EpiProj E{P};
        pg8::gemm_phase<EpiProj>(ldsl, g, S, E);
        pg8::Unit u;
        for (int i = 0; S.next(i, u); ++i) if (u.pn == 16) ckv_norm_rows(P, u.pm * 256, 256, tid);
    }
    SEAM(1);
    if (IN(2) && !(DBG & 1)) {
        if (blockIdx.x < 64) rglru_item(P, lds, (int)blockIdx.x >> 4, (int)blockIdx.x & 15, tid);
        if (tid < 64) ((volatile unsigned*)(lds + 147456))[tid] = 0u;
        __syncthreads();
        const int hb = ((int)blockIdx.x & 7) >> 1;
        for (int k = 0; k < NB; ++k) {
            const int b = (hb + k) & 3;
            for (;;) {
                __syncthreads();
                if (tid == 0) *(volatile int*)(lds + 147712) = (int)atomicAdd(ctl + 64 * b, 1u);
                __syncthreads();
                const int item = *(volatile int*)(lds + 147712);
                if (item >= T / 4) break;
                attn_item(P, lds, b, 4 * ((T / 4 - 1) - item), tid);
            }
        }
    }
    SEAM(2);
    if (IN(3)) {
        pg8::Gemm g{P.QL, P.WuvT, 512, 4096, 512, 512}; pg8::StaticOrder S; S.init(M, 2048, G, (int)blockIdx.x);
        EpiGate<0> E{P.AG, nullptr};
        pg8::gemm_phase<EpiGate<0>, true>(ldsl, g, S, E);
    }
    SEAM(3);
    if (IN(4)) {
        pg8::StaticOrder S; S.init(M, 2048, G, (int)blockIdx.x);
        { pg8::Gemm g{P.AG, P.WaT, 2048, 2048, 2048, 0}; EpiGate<1> E{P.XR, P.GA}; pg8::gemm_phase<EpiGate<1>>(ldsl, g, S, E); }
        { pg8::Gemm g{P.RG, P.WbT, 2048, 2048, 2048, 0}; EpiGate<2> E{P.XR, P.GB}; pg8::gemm_phase<EpiGate<2>>(ldsl, g, S, E); }
    }
    SEAM(4);
    if (IN(5)) {
        pg8::Gemm g{P.XR, P.WoT, 2048, 2048, 2048, 0}; pg8::StaticOrder S; S.init(M, 2048, G, (int)blockIdx.x);
        EpiOut E{P.x, P.out};
        pg8::gemm_phase<EpiOut>(ldsl, g, S, E);
    }
    SEAM(5);
    if (IN(6)) { ln_rows(P, tid, G); }
#undef IN
#undef SEAM
}

extern "C" void kernel_launch(void* const* d_in, const int* in_sizes, int n_in, void* d_out, int out_size, void* d_ws, size_t ws_size, hipStream_t stream) {
    static int grid = 0;
    if (grid == 0) {
        if (n_in != 17 || out_size != M * D || ws_size < WS_END) { fprintf(stderr, "kernel_launch: unexpected shapes (n_in %d out %d ws %zu)\n", n_in, out_size, ws_size); grid = -1; return; }
        int dev = 0, cus = 0, per_cu = 0;
        hipGetDevice(&dev); hipDeviceGetAttribute(&cus, hipDeviceAttributeMultiprocessorCount, dev);
        if (hipFuncSetAttribute((const void*)mega_fwd, hipFuncAttributeMaxDynamicSharedMemorySize, LDS_BYTES) != hipSuccess) { fprintf(stderr, "kernel_launch: hipFuncSetAttribute failed\n"); grid = -1; return; }
        if (hipOccupancyMaxActiveBlocksPerMultiprocessor(&per_cu, (const void*)mega_fwd, 512, LDS_BYTES) != hipSuccess || per_cu < 1) { fprintf(stderr, "kernel_launch: occupancy query says %d\n", per_cu); per_cu = 1; }
        (void)hipGetLastError();
        grid = cus * per_cu;
    }
    if (grid < 0) return;
    Args a{};
    for (int i = 0; i < 17; ++i) a.in[i] = (const float*)d_in[i];
    a.out = (float*)d_out; a.ws = (unsigned char*)d_ws;
#if N_LAUNCHES == 1
    a.ph_lo = 0; a.ph_hi = NPH;
    void* kargs[] = {&a};
    hipError_t e = hipLaunchCooperativeKernel((const void*)mega_fwd, dim3(grid), dim3(512), kargs, LDS_BYTES, stream);
    if (e != hipSuccess) fprintf(stderr, "cooperative launch failed: %s (grid %d)\n", hipGetErrorString(e), grid);
#else
    for (int ph = 0; ph < NPH; ++ph) { a.ph_lo = ph; a.ph_hi = ph + 1;
        hipLaunchKernelGGL(mega_fwd, dim3(grid), dim3(512), LDS_BYTES, stream, a); }
#endif
}
```

```cpp
#include <hip/hip_runtime.h>
#include <hip/hip_cooperative_groups.h>
#include <cstdio>
#include <cstdint>
namespace cg = cooperative_groups;

#ifndef DBG
#define DBG 0
#endif
#ifndef N_LAUNCHES
#define N_LAUNCHES 1
#endif

namespace pg8 {
#define PG8_LAS __attribute__((address_space(3)))
typedef unsigned short bf16_t;
typedef short bf16x8 __attribute__((ext_vector_type(8)));
typedef float f32x4 __attribute__((ext_vector_type(4)));
typedef unsigned u32x4 __attribute__((ext_vector_type(4)));
constexpr int BM = 256, BK = 64, HALF = 128, HTB = HALF * BK * 2, STAGE_BYTES = 8 * HTB, NXCD = 8, WGM = 4;

__host__ __device__ __forceinline__ int lds_byte(int r, int c) { const int st = (r >> 4) * 2 + (c >> 5), rr = r & 15, cc = c & 31, ob = rr * 64 + cc * 2; return st * 1024 + (ob ^ (((ob >> 9) & 1) << 5)); }
__host__ __device__ __forceinline__ void stage_rc(int b, int& R, int& C) { const int st = b / 1024, sb = b % 1024, swz = sb ^ (((sb >> 9) & 1) << 5); R = (st >> 1) * 16 + swz / 64; C = (st & 1) * 32 + (swz % 64) / 2; }
__host__ __device__ __forceinline__ int perm32(int rho) { const int n = rho >> 4, i = rho & 15; return 8 * (i >> 2) + 4 * n + (i & 3); }

struct Unit { int pm, pn; };
struct Gemm { const bf16_t* A; const bf16_t* Bt; int K, lda, ldb, apn; };

struct StaticOrder {
    int nM, nN, nwg, G, c;
    __host__ __device__ __forceinline__ void init(int M, int N, int G_, int c_) { nM = M / BM; nN = N / BM; nwg = nM * nN; G = G_; c = c_; }
    __host__ __device__ __forceinline__ bool next(int i, Unit& u) const {
        const long L = (long)i * G + c; if (L >= nwg) return false;
        int wgid = (int)L; { const int q = nwg / NXCD, r = nwg % NXCD, xcd = wgid % NXCD, off = wgid / NXCD; wgid = (xcd < r ? xcd * (q + 1) : r * (q + 1) + (xcd - r) * q) + off; }
        const int nig = WGM * nN, gid = wgid / nig, fm = gid * WGM, gsz = (nM - fm) < WGM ? (nM - fm) : WGM;
        u.pm = fm + ((wgid % nig) % gsz); u.pn = (wgid % nig) / gsz; return true;
    }
};

__device__ __forceinline__ unsigned cvt_pk_bf16(float lo, float hi) { unsigned r; asm volatile("v_cvt_pk_bf16_f32 %0, %1, %2" : "=v"(r) : "v"(lo), "v"(hi)); return r; }

template <class Epi, bool BLKDIAG = false>
__device__ __forceinline__ void gemm_phase(PG8_LAS unsigned char* lds, const Gemm g, const StaticOrder& S, const Epi& E) {
    const int tid = threadIdx.x, wid = __builtin_amdgcn_readfirstlane(tid >> 6), lane = tid & 63, wr = wid >> 2, wc = wid & 3, fr = lane & 15, fq = lane >> 4;
    const int K = g.K, nt = K / BK;
    unsigned voffA[2], voffB[2];
#pragma unroll
    for (int i = 0; i < 2; ++i) { int R, C; stage_rc(tid * 16 + i * 8192, R, C); const int Rb = (R & ~31) + perm32(R & 31);
        voffA[i] = (unsigned)(R * g.lda + C) * 2u; voffB[i] = (unsigned)(Rb * g.ldb + C) * 2u; }
    const size_t kstep = (size_t)(BK * 2);
    const size_t hstepA = (size_t)HALF * g.lda * 2, hstepB = (size_t)HALF * g.ldb * 2;
    const size_t tstepA = 2 * hstepA, tstepB = 2 * hstepB;
    const unsigned ldsw = (unsigned)wid * 1024u;
    const int aoff = lds_byte(wr * 64 + fr, fq * 8), boff = lds_byte(wc * 32 + fr, fq * 8);
#define PG8_SA(b, h) (((b) * 2 + (h)) * HTB)
#define PG8_SB(b, h) ((4 + (b) * 2 + (h)) * HTB)
#define PG8_STAGE(bufoff, gbase, voff) do { _Pragma("unroll") for (int _i = 0; _i < 2; ++_i) \
        __builtin_amdgcn_global_load_lds((const unsigned*)((const char*)(gbase) + (voff)[_i]), (PG8_LAS unsigned*)(lds + (bufoff) + ldsw + _i * 8192), 16, 0, 0); } while (0)
#define PG8_LDA(dst, b, h) do { _Pragma("unroll") for (int m = 0; m < 4; ++m) _Pragma("unroll") for (int k = 0; k < 2; ++k) dst[m][k] = *(const PG8_LAS bf16x8*)(lds + PG8_SA(b, h) + aoff + m * 2048 + k * 1024); } while (0)
#define PG8_LDB(dst, b, h) do { _Pragma("unroll") for (int n = 0; n < 2; ++n) _Pragma("unroll") for (int k = 0; k < 2; ++k) dst[n][k] = *(const PG8_LAS bf16x8*)(lds + PG8_SB(b, h) + boff + n * 2048 + k * 1024); } while (0)
#define PG8_MMA(ai, bj, At, Bt) do { __builtin_amdgcn_s_setprio(1); _Pragma("unroll") for (int m = 0; m < 4; ++m) _Pragma("unroll") for (int n = 0; n < 2; ++n) _Pragma("unroll") for (int k = 0; k < 2; ++k) \
        acc[ai][bj][m][n] = __builtin_amdgcn_mfma_f32_16x16x32_bf16(Bt[n][k], At[m][k], acc[ai][bj][m][n], 0, 0, 0); __builtin_amdgcn_s_setprio(0); } while (0)
#define PG8_WAIT_V(n) asm volatile("s_waitcnt vmcnt(" #n ")" ::: "memory")
#define PG8_WAIT_L(n) asm volatile("s_waitcnt lgkmcnt(" #n ")" ::: "memory")
#define PG8_BAR __builtin_amdgcn_s_barrier()
#define PG8_SCHED __builtin_amdgcn_sched_barrier(0)
    Unit cur, nxt; int ui = 0;
    if (!S.next(0, cur)) return;
    f32x4 acc[2][2][4][2];
#pragma unroll
    for (int a = 0; a < 2; ++a)
#pragma unroll
        for (int b = 0; b < 2; ++b)
#pragma unroll
            for (int m = 0; m < 4; ++m)
#pragma unroll
                for (int n = 0; n < 2; ++n) acc[a][b][m][n] = (f32x4){0.f, 0.f, 0.f, 0.f};
    bf16x8 At[4][2], B0[2][2], B1[2][2];
    const char* cA = (const char*)g.A + (size_t)cur.pm * tstepA + (size_t)cur.pn * g.apn * 2; const char* cB = (const char*)g.Bt + (size_t)cur.pn * tstepB;
    PG8_STAGE(PG8_SB(0, 0), cB, voffB); PG8_STAGE(PG8_SB(0, 1), cB + hstepB, voffB); PG8_STAGE(PG8_SA(0, 0), cA, voffA); PG8_STAGE(PG8_SA(0, 1), cA + hstepA, voffA);
    if (wr == 1) PG8_BAR;
    PG8_WAIT_V(2); PG8_BAR;
    PG8_STAGE(PG8_SB(1, 0), cB + kstep, voffB); PG8_STAGE(PG8_SA(1, 0), cA + kstep, voffA); PG8_STAGE(PG8_SB(1, 1), cB + hstepB + kstep, voffB);
    PG8_WAIT_V(6); PG8_BAR;
    for (;;) {
        const bool has_next = S.next(ui + 1, nxt);
        const char* nA = has_next ? (const char*)g.A + (size_t)nxt.pm * tstepA + (size_t)nxt.pn * g.apn * 2 : cA; const char* nB = has_next ? (const char*)g.Bt + (size_t)nxt.pn * tstepB : cB;
        for (int t = 0; t < nt; t += 2) {
            const bool last = (t == nt - 2);
            const bool lo_ = BLKDIAG ? (t < nt / 2) : true, hi_ = BLKDIAG ? !lo_ : true;
            const char* a1 = cA + (size_t)(t + 1) * kstep;
            const char* a2 = last ? nA : cA + (size_t)(t + 2) * kstep; const char* b2 = last ? nB : cB + (size_t)(t + 2) * kstep;
            const char* a3 = a2 + kstep; const char* b3 = b2 + kstep;
            PG8_LDB(B0, 0, 0); PG8_LDB(B1, 0, 1); PG8_SCHED; PG8_LDA(At, 0, 0); PG8_STAGE(PG8_SA(1, 1), a1 + hstepA, voffA);
            PG8_WAIT_V(8); PG8_WAIT_L(0); PG8_BAR; if (lo_) PG8_MMA(0, 0, At, B0); if (hi_) PG8_MMA(0, 1, At, B1); PG8_BAR; PG8_SCHED;
            PG8_LDA(At, 0, 1); PG8_STAGE(PG8_SB(0, 0), b2, voffB); PG8_STAGE(PG8_SB(0, 1), b2 + hstepB, voffB); PG8_STAGE(PG8_SA(0, 0), a2, voffA);
            PG8_WAIT_V(8); PG8_WAIT_L(0); PG8_BAR; if (lo_) PG8_MMA(1, 0, At, B0); if (hi_) PG8_MMA(1, 1, At, B1); PG8_BAR; PG8_SCHED;
            PG8_LDB(B0, 1, 0); PG8_LDB(B1, 1, 1); PG8_SCHED; PG8_LDA(At, 1, 0); PG8_STAGE(PG8_SA(0, 1), a2 + hstepA, voffA);
            PG8_WAIT_V(8); PG8_WAIT_L(0); PG8_BAR; if (lo_) PG8_MMA(0, 0, At, B0); if (hi_) PG8_MMA(0, 1, At, B1); PG8_BAR; PG8_SCHED;
            PG8_LDA(At, 1, 1); PG8_STAGE(PG8_SB(1, 0), b3, voffB); PG8_STAGE(PG8_SB(1, 1), b3 + hstepB, voffB); PG8_STAGE(PG8_SA(1, 0), a3, voffA);
            PG8_WAIT_V(8); PG8_WAIT_L(0); PG8_BAR; if (lo_) PG8_MMA(1, 0, At, B0); if (hi_) PG8_MMA(1, 1, At, B1); PG8_BAR; PG8_SCHED;
        }
        if (wr == 0) PG8_BAR;
        E(acc, cur, wr, wc, fr, fq);
        if (!has_next) break;
#pragma unroll
        for (int a = 0; a < 2; ++a)
#pragma unroll
            for (int b = 0; b < 2; ++b)
#pragma unroll
                for (int m = 0; m < 4; ++m)
#pragma unroll
                    for (int n = 0; n < 2; ++n) acc[a][b][m][n] = (f32x4){0.f, 0.f, 0.f, 0.f};
        cur = nxt; cA = nA; cB = nB; ++ui;
        if (wr == 1) PG8_BAR;
    }
    PG8_WAIT_V(0);
    PG8_BAR;
#undef PG8_SA
#undef PG8_SB
#undef PG8_STAGE
#undef PG8_LDA
#undef PG8_LDB
#undef PG8_MMA
#undef PG8_WAIT_V
#undef PG8_WAIT_L
#undef PG8_BAR
#undef PG8_SCHED
}
}

using pg8::bf16_t; using pg8::bf16x8; using pg8::f32x4; using pg8::u32x4; using pg8::cvt_pk_bf16;
typedef short s16x4 __attribute__((ext_vector_type(4)));
__device__ __forceinline__ f32x4 mfma16(bf16x8 a, bf16x8 b, f32x4 c) { const f32x4 r = __builtin_amdgcn_mfma_f32_16x16x32_bf16(a, b, c, 0, 0, 0); asm volatile("" :: "v"(a), "v"(b)); return r; }
#define LAS __attribute__((address_space(3)))

constexpr int NB = 4, T = 8192, D = 2048, M = NB * T;
constexpr int NP = 15872;
constexpr float LN_EPS = 1e-5f;
constexpr float ALPHA = 1.189207115002721f;
constexpr size_t MiB = 1u << 20;
constexpr size_t WS_CTL = 0;
constexpr size_t WS_BT = 1 * MiB;
constexpr size_t WS_WIN = 2 * MiB;
constexpr size_t WS_WUV = 64 * MiB;
constexpr size_t WS_WA = 66 * MiB, WS_WB = 74 * MiB, WS_WO = 82 * MiB;
constexpr size_t WS_WGA = 90 * MiB, WS_WGX = 90 * MiB + 512 * 1024;
constexpr size_t WS_QL = 96 * MiB;
constexpr size_t WS_CKV = 352 * MiB;
constexpr size_t WS_AG = 368 * MiB;
constexpr size_t WS_QI = 496 * MiB;
constexpr size_t WS_KI = 560 * MiB;
constexpr size_t WS_WI = 564 * MiB;
constexpr size_t WS_XR = 568 * MiB;
constexpr size_t WS_RG = 696 * MiB;
constexpr size_t WS_GB = 824 * MiB;
constexpr size_t WS_CKVF = 952 * MiB;
constexpr size_t WS_END = 984 * MiB;
constexpr int LDS_BYTES = 151552;

__device__ __forceinline__ float shfl_xor_safe(float v, int m) { float r = __shfl_xor(v, m); asm volatile("s_waitcnt lgkmcnt(0)" : "+v"(r)); return r; }
__device__ __forceinline__ void lgkm_fence4(float& a, float& b, float& c, float& d) { asm volatile("s_waitcnt lgkmcnt(0)" : "+v"(a), "+v"(b), "+v"(c), "+v"(d)); }
template <int CTRL> __device__ __forceinline__ float dpp_f(float v) { return __builtin_bit_cast(float, __builtin_amdgcn_update_dpp(0, __builtin_bit_cast(int, v), CTRL, 0xf, 0xf, true)); }
__device__ __forceinline__ float row16_sum(float v) { v += dpp_f<0x121>(v); v += dpp_f<0x122>(v); v += dpp_f<0x124>(v); v += dpp_f<0x128>(v); return v; }
__device__ __forceinline__ float row16_max(float v) { v = fmaxf(v, dpp_f<0x121>(v)); v = fmaxf(v, dpp_f<0x122>(v)); v = fmaxf(v, dpp_f<0x124>(v)); v = fmaxf(v, dpp_f<0x128>(v)); return v; }
__device__ __forceinline__ float rows4_sum(float v) {
    float a = v, b = v;
    asm("s_nop 1\n\tv_permlane32_swap_b32 %0, %1" : "+v"(a), "+v"(b));
    float s = a + b, t = s;
    asm("s_nop 1\n\tv_permlane16_swap_b32 %0, %1" : "+v"(s), "+v"(t));
    return s + t; }
template <int CTRL> __device__ __forceinline__ unsigned dpp_u(unsigned v) { return (unsigned)__builtin_amdgcn_update_dpp(0, (int)v, CTRL, 0xf, 0xf, true); }
__device__ __forceinline__ unsigned wave_incl_scan(unsigned v, int lane) {
    v += dpp_u<0x111>(v); v += dpp_u<0x112>(v); v += dpp_u<0x114>(v); v += dpp_u<0x118>(v);
    const unsigned r0 = (unsigned)__builtin_amdgcn_readlane((int)v, 15), r1 = (unsigned)__builtin_amdgcn_readlane((int)v, 31), r2 = (unsigned)__builtin_amdgcn_readlane((int)v, 47);
    const int row = lane >> 4;
    return v + (row >= 1 ? r0 : 0u) + (row >= 2 ? r1 : 0u) + (row >= 3 ? r2 : 0u); }
__device__ __forceinline__ float bf2f(unsigned short u) { return __builtin_bit_cast(float, (unsigned)u << 16); }
__device__ __forceinline__ float bflo(unsigned w) { return __builtin_bit_cast(float, w << 16); }
__device__ __forceinline__ float bfhi(unsigned w) { return __builtin_bit_cast(float, w & 0xffff0000u); }
__device__ __forceinline__ float fsigmoid(float v) { return __builtin_amdgcn_rcpf(1.f + __expf(-v)); }

struct Ptrs {
    const float *x, *w_in, *kvg, *w_uv, *w_a, *conv_w, *conv_b, *wga, *bga, *wgx, *bgx, *lam, *w_b, *relb, *w_o, *ln_g, *ln_b;
    float* out; unsigned char* ws;
    bf16_t *WinT, *WuvT, *WaT, *WbT, *WoT, *WgaT, *WgxT, *QL, *CKV, *AG, *QI, *KI, *XR, *RG, *GB, *XB, *GA;
    float *WI, *CKVF, *BT;
};

struct EpiProj {
    Ptrs P;
    __device__ __forceinline__ void operator()(const f32x4 (&acc)[2][2][4][2], const pg8::Unit& u, int wr, int wc, int fr, int fq) const {
        const int pn = u.pn; const int row0 = u.pm * 256 + wr * 64 + fr, cl0 = wc * 32 + 8 * fq;
        int kind = 0, ld = 0, coff = 0; bf16_t* dst = nullptr;
        if (pn < 16) { dst = P.QL; ld = 4096; coff = pn * 256; }
        else if (pn == 16) { kind = 3; }
        else if (pn < 25) { dst = P.AG; ld = 2048; coff = (pn - 17) * 256; kind = 1; }
        else if (pn < 29) { dst = P.QI; ld = 1024; coff = (pn - 25) * 256; }
        else if (pn == 29) { kind = 4; }
        else if (pn < 38) { dst = P.XR; ld = 2048; coff = (pn - 30) * 256; }
        else if (pn < 46) { dst = P.RG; ld = 2048; coff = (pn - 38) * 256; kind = 1; }
        else if (pn < 54) { dst = P.GA; ld = 2048; coff = (pn - 46) * 256; kind = 2; }
        else { dst = P.GB; ld = 2048; coff = (pn - 54) * 256; kind = 2; }
#pragma unroll
        for (int ai = 0; ai < 2; ++ai)
#pragma unroll
            for (int m = 0; m < 4; ++m) { const size_t row = (size_t)(row0 + ai * 128 + m * 16);
#pragma unroll
                for (int bj = 0; bj < 2; ++bj) { const int cl = cl0 + bj * 128; f32x4 v0 = acc[ai][bj][m][0], v1 = acc[ai][bj][m][1];
                    if (kind <= 2) {
                        if (kind == 1) {
#pragma unroll
                            for (int e = 0; e < 4; ++e) { v0[e] = v0[e] * fsigmoid(v0[e]); v1[e] = v1[e] * fsigmoid(v1[e]); }
                        } else if (kind == 2) {
#pragma unroll
                            for (int e = 0; e < 4; ++e) { v0[e] = fsigmoid(v0[e]); v1[e] = fsigmoid(v1[e]); }
                        }
                        u32x4 w; w.x = cvt_pk_bf16(v0[0], v0[1]); w.y = cvt_pk_bf16(v0[2], v0[3]); w.z = cvt_pk_bf16(v1[0], v1[1]); w.w = cvt_pk_bf16(v1[2], v1[3]);
                        *(u32x4*)(dst + row * ld + coff + cl) = w;
                    } else if (kind == 3) {
                        float* p = P.CKVF + row * 256 + cl; *(f32x4*)p = v0; *(f32x4*)(p + 4) = v1;
                    } else {
                        if (cl < 64) { u32x4 w; w.x = cvt_pk_bf16(v0[0], v0[1]); w.y = cvt_pk_bf16(v0[2], v0[3]); w.z = cvt_pk_bf16(v1[0], v1[1]); w.w = cvt_pk_bf16(v1[2], v1[3]);
                            *(u32x4*)(P.KI + row * 64 + cl) = w; }
                        else if (cl < 80) { float* p = P.WI + row * 16 + (cl - 64); *(f32x4*)p = v0; *(f32x4*)(p + 4) = v1; }
                    }
                } }
    }
};
template <int MODE> struct EpiGate {
    bf16_t* O; const bf16_t* G;
    __device__ __forceinline__ void operator()(const f32x4 (&acc)[2][2][4][2], const pg8::Unit& u, int wr, int wc, int fr, int fq) const {
        const int row0 = u.pm * 256 + wr * 64 + fr, col0 = u.pn * 256 + wc * 32 + 8 * fq;
#pragma unroll
        for (int ai = 0; ai < 2; ++ai)
#pragma unroll
            for (int m = 0; m < 4; ++m) { const size_t row = (size_t)(row0 + ai * 128 + m * 16);
#pragma unroll
                for (int bj = 0; bj < 2; ++bj) { const size_t off = row * 2048 + col0 + bj * 128; const f32x4 v0 = acc[ai][bj][m][0], v1 = acc[ai][bj][m][1];
                    float r[8];
                    if (MODE == 0) { const u32x4 o = *(const u32x4*)(O + off);
                        r[0] = bflo(o.x) * v0[0]; r[1] = bfhi(o.x) * v0[1]; r[2] = bflo(o.y) * v0[2]; r[3] = bfhi(o.y) * v0[3];
                        r[4] = bflo(o.z) * v1[0]; r[5] = bfhi(o.z) * v1[1]; r[6] = bflo(o.w) * v1[2]; r[7] = bfhi(o.w) * v1[3]; }
                    else { const u32x4 gq = *(const u32x4*)(G + off);
                        r[0] = bflo(gq.x) * v0[0]; r[1] = bfhi(gq.x) * v0[1]; r[2] = bflo(gq.y) * v0[2]; r[3] = bfhi(gq.y) * v0[3];
                        r[4] = bflo(gq.z) * v1[0]; r[5] = bfhi(gq.z) * v1[1]; r[6] = bflo(gq.w) * v1[2]; r[7] = bfhi(gq.w) * v1[3];
                        if (MODE == 2) { const u32x4 o = *(const u32x4*)(O + off);
                            r[0] += bflo(o.x); r[1] += bfhi(o.x); r[2] += bflo(o.y); r[3] += bfhi(o.y); r[4] += bflo(o.z); r[5] += bfhi(o.z); r[6] += bflo(o.w); r[7] += bfhi(o.w); } }
                    u32x4 w; w.x = cvt_pk_bf16(r[0], r[1]); w.y = cvt_pk_bf16(r[2], r[3]); w.z = cvt_pk_bf16(r[4], r[5]); w.w = cvt_pk_bf16(r[6], r[7]);
                    *(u32x4*)(O + off) = w; } }
    }
};
struct EpiOut {
    const float* X; float* Y;
    __device__ __forceinline__ void operator()(const f32x4 (&acc)[2][2][4][2], const pg8::Unit& u, int wr, int wc, int fr, int fq) const {
        const int row0 = u.pm * 256 + wr * 64 + fr, col0 = u.pn * 256 + wc * 32 + 8 * fq;
#pragma unroll
        for (int ai = 0; ai < 2; ++ai)
#pragma unroll
            for (int m = 0; m < 4; ++m) { const size_t row = (size_t)(row0 + ai * 128 + m * 16);
#pragma unroll
                for (int bj = 0; bj < 2; ++bj) { const size_t off = row * 2048 + col0 + bj * 128;
                    const f32x4 x0 = *(const f32x4*)(X + off), x1 = *(const f32x4*)(X + off + 4);
                    *(f32x4*)(Y + off) = x0 * ALPHA + acc[ai][bj][m][0]; *(f32x4*)(Y + off + 4) = x1 * ALPHA + acc[ai][bj][m][1]; } }
    }
};

__device__ __forceinline__ void tr_item(const float* W, int ldw, int k0, int n0, int nv, bf16_t* WT, int ldt, int drow0, int dcol0, float* scr, int lane) {
    float wv[32];
#pragma unroll
    for (int i = 0; i < 32; ++i) { const int kk = 2 * i + (lane >> 5), nn = lane & 31; wv[i] = nn < nv ? W[(size_t)(k0 + kk) * ldw + n0 + nn] : 0.f; }
#pragma unroll
    for (int i = 0; i < 32; ++i) { const int kk = 2 * i + (lane >> 5), nn = lane & 31; scr[kk * 33 + nn] = wv[i]; }
    asm volatile("s_waitcnt lgkmcnt(0)" ::: "memory");
    const int c = lane & 7;
#pragma unroll
    for (int j = 0; j < 4; ++j) { const int n = (lane >> 3) + 8 * j; const float* s = scr + (8 * c) * 33 + n;
        u32x4 o; o.x = cvt_pk_bf16(s[0 * 33], s[1 * 33]); o.y = cvt_pk_bf16(s[2 * 33], s[3 * 33]); o.z = cvt_pk_bf16(s[4 * 33], s[5 * 33]); o.w = cvt_pk_bf16(s[6 * 33], s[7 * 33]);
        if (n < nv) *(u32x4*)(WT + (size_t)(drow0 + n) * ldt + dcol0 + k0 + 8 * c) = o; }
    asm volatile("s_waitcnt lgkmcnt(0)" ::: "memory");
}
__device__ __forceinline__ void p0_prologue(const Ptrs& P, unsigned char* lds, int tid, int G) {
    const int lane = tid & 63, wave = __builtin_amdgcn_readfirstlane(tid >> 6);
    float* scr = (float*)(lds + wave * 8448);
    const int gw = blockIdx.x * 8 + wave, NGW = G * 8;
    for (int it = gw; it < 491 * 32; it += NGW) { const int ci = it >> 5, kb = it & 31; int n0, nv = 32, dr;
        if (ci < 234) { n0 = 32 * ci; dr = n0; } else if (ci == 234) { n0 = 7488; nv = 16; dr = n0; } else { n0 = 7504 + 32 * (ci - 235); dr = n0 + 176; }
        tr_item(P.w_in, 15696, 64 * kb, n0, nv, P.WinT, 2048, dr, 0, scr, lane); }
    for (int it = gw; it < 2048; it += NGW) { const int kb = it >> 6, nb = it & 63; tr_item(P.w_a, 2048, 64 * kb, 32 * nb, 32, P.WaT, 2048, 32 * nb, 0, scr, lane); }
    for (int it = gw; it < 2048; it += NGW) { const int kb = it >> 6, nb = it & 63; tr_item(P.w_b, 2048, 64 * kb, 32 * nb, 32, P.WbT, 2048, 32 * nb, 0, scr, lane); }
    for (int it = gw; it < 2048; it += NGW) { const int kb = it >> 6, nb = it & 63; tr_item(P.w_o, 2048, 64 * kb, 32 * nb, 32, P.WoT, 2048, 32 * nb, 0, scr, lane); }
    for (int it = gw; it < 256; it += NGW) { const int h = it >> 4, kb = (it >> 2) & 3, nb = it & 3;
        tr_item(P.w_uv + (size_t)h * 32768, 128, 64 * kb, 32 * nb, 32, P.WuvT, 512, h * 128 + 32 * nb, (h & 1) * 256, scr, lane); }
    for (int it = gw; it < 128; it += NGW) { const int n = (it >> 3) & 15, kb = (it >> 2) & 1, nb = it & 3;
        tr_item(P.wga + (size_t)n * 16384, 128, 64 * kb, 32 * nb, 32, P.WgaT, 128, n * 128 + 32 * nb, 0, scr, lane); }
    for (int it = gw; it < 128; it += NGW) { const int n = (it >> 3) & 15, kb = (it >> 2) & 1, nb = it & 3;
        tr_item(P.wgx + (size_t)n * 16384, 128, 64 * kb, 32 * nb, 32, P.WgxT, 128, n * 128 + 32 * nb, 0, scr, lane); }
    const size_t gt = (size_t)blockIdx.x * 512 + tid, GT = (size_t)G * 512;
    const u32x4 z = {0u, 0u, 0u, 0u};
    for (size_t i = gt; i < 176 * 256; i += GT) *(u32x4*)(P.WinT + (size_t)7504 * 2048 + i * 8) = z;
    for (size_t i = gt; i < 2048 * 32; i += GT) { const size_t r = i >> 5, c = i & 31; *(u32x4*)(P.WuvT + r * 512 + ((((r >> 7) & 1) ^ 1) * 256) + c * 8) = z; }
#pragma unroll 4
    for (size_t i = gt; i < (size_t)M * D / 8; i += GT) { const f32x4 a = *(const f32x4*)(P.x + i * 8), b = *(const f32x4*)(P.x + i * 8 + 4);
        u32x4 w; w.x = cvt_pk_bf16(a[0], a[1]); w.y = cvt_pk_bf16(a[2], a[3]); w.z = cvt_pk_bf16(b[0], b[1]); w.w = cvt_pk_bf16(b[2], b[3]); *(u32x4*)(P.XB + i * 8) = w; }
    for (size_t i = gt; i < 129 * 16; i += GT) { const int n = (int)(i >> 4), h = (int)(i & 15); int bk;
        if (n < 16) bk = n; else { bk = 16 + (int)(logf((float)n / 16.f) / 2.0794415416798357f * 16.f); bk = bk > 31 ? 31 : bk; }
        P.BT[i] = P.relb[bk * 16 + h]; }
}

__device__ __forceinline__ void ckv_norm_rows(const Ptrs& P, int row0, int nrows, int tid) {
    const int lane = tid & 63, wave = tid >> 6;
    const f32x4 gq = *(const f32x4*)(P.kvg + 4 * lane);
    for (int r0 = wave; r0 < nrows; r0 += 64) {
        f32x4 v[8];
#pragma unroll
        for (int k = 0; k < 8; ++k) { const int r = r0 + 8 * k; v[k] = *(const f32x4*)(P.CKVF + ((size_t)row0 + (r < nrows ? r : r0)) * 256 + 4 * lane); }
#pragma unroll
        for (int k = 0; k < 8; ++k) { const int r = r0 + 8 * k;
            float s = v[k][0] * v[k][0] + v[k][1] * v[k][1] + v[k][2] * v[k][2] + v[k][3] * v[k][3];
            s = rows4_sum(row16_sum(s));
            const float rs = 1.f / sqrtf(s * (1.f / 256.f) + LN_EPS);
            uint2 w; w.x = cvt_pk_bf16(v[k][0] * rs * gq[0], v[k][1] * rs * gq[1]); w.y = cvt_pk_bf16(v[k][2] * rs * gq[2], v[k][3] * rs * gq[3]);
            if (r < nrows) *(uint2*)(P.CKV + ((size_t)row0 + r) * 256 + 4 * lane) = w; }
    }
}

__device__ __forceinline__ float em1_poly(float x) { return x * (1.f + x * (0.5f + x * (0.16666667f + x * (0.041666668f + x * (0.0083333338f + x * 0.0013888889f))))); }
#define BAR_LDS() asm volatile("s_waitcnt lgkmcnt(0)\n\ts_barrier" ::: "memory")
__device__ __forceinline__ void rglru_item(const Ptrs& P, unsigned char* lds, int b, int n, int tid) {
    const int lane = tid & 63, w = __builtin_amdgcn_readfirstlane(tid >> 6), g = lane >> 4, r16 = lane & 15;
    bf16_t* XCb = (bf16_t*)lds;
    float* XCf = (float*)(lds + 17408);
    float* LA = (float*)(lds + 17408 + 32768);
    float* LB = LA + 8192;
    const size_t rowb = (size_t)b * T;
    const int ce = 16 * w + r16, ch = n * 128 + ce;
    bf16x8 Ba[4], Bx[4];
#pragma unroll
    for (int ks = 0; ks < 4; ++ks) { Ba[ks] = *(const bf16x8*)(P.WgaT + (size_t)ch * 128 + 32 * ks + 8 * g); Bx[ks] = *(const bf16x8*)(P.WgxT + (size_t)ch * 128 + 32 * ks + 8 * g); }
    const float ba = P.bga[ch], bx = P.bgx[ch];
    const float sp8 = 8.f * log1pf(expf(-P.lam[ch]));
    const bool big = __any(sp8 > 0.14f);
    float h = 0.f;
    const int tt = tid >> 3, c0 = (tid & 7) * 16, cg0 = n * 128 + c0;
    u32x4 xr[4][2];
#define RG_LOAD(T0) do { _Pragma("unroll") for (int k = 0; k < 4; ++k) { int tk = (T0) + tt - 3 + k; tk = tk < 0 ? 0 : tk; const bf16_t* xp = P.XR + (rowb + tk) * 2048 + cg0; \
            xr[k][0] = *(const u32x4*)xp; xr[k][1] = *(const u32x4*)(xp + 8); } } while (0)
    RG_LOAD(0);
    for (int chunk = 0; chunk < T / 64; ++chunk) {
        const int t0 = chunk * 64;
        u32x4 gc0, gc1;
        {
            float xc[16];
#pragma unroll
            for (int e = 0; e < 16; e += 4) { const f32x4 v = *(const f32x4*)(P.conv_b + cg0 + e); xc[e] = v[0]; xc[e + 1] = v[1]; xc[e + 2] = v[2]; xc[e + 3] = v[3]; }
#pragma unroll
            for (int k = 0; k < 4; ++k) { const float m = (t0 + tt - 3 + k) >= 0 ? 1.f : 0.f;
                float cwk[16];
#pragma unroll
                for (int e = 0; e < 16; e += 4) { const f32x4 c = *(const f32x4*)(P.conv_w + k * 2048 + cg0 + e); cwk[e] = c[0]; cwk[e + 1] = c[1]; cwk[e + 2] = c[2]; cwk[e + 3] = c[3]; }
                const u32x4 xa = xr[k][0], xb2 = xr[k][1];
                const float xv[16] = {bflo(xa.x), bfhi(xa.x), bflo(xa.y), bfhi(xa.y), bflo(xa.z), bfhi(xa.z), bflo(xa.w), bfhi(xa.w),
                                      bflo(xb2.x), bfhi(xb2.x), bflo(xb2.y), bfhi(xb2.y), bflo(xb2.z), bfhi(xb2.z), bflo(xb2.w), bfhi(xb2.w)};
#pragma unroll
                for (int e = 0; e < 16; ++e) xc[e] += (cwk[e] * m) * xv[e]; }
#pragma unroll
            for (int e = 0; e < 16; e += 4) *(f32x4*)(XCf + tt * 128 + c0 + e) = (f32x4){xc[e], xc[e + 1], xc[e + 2], xc[e + 3]};
            u32x4 w0, w1; w0.x = cvt_pk_bf16(xc[0], xc[1]); w0.y = cvt_pk_bf16(xc[2], xc[3]); w0.z = cvt_pk_bf16(xc[4], xc[5]); w0.w = cvt_pk_bf16(xc[6], xc[7]);
            w1.x = cvt_pk_bf16(xc[8], xc[9]); w1.y = cvt_pk_bf16(xc[10], xc[11]); w1.z = cvt_pk_bf16(xc[12], xc[13]); w1.w = cvt_pk_bf16(xc[14], xc[15]);
            *(u32x4*)(XCb + tt * 136 + c0) = w0; *(u32x4*)(XCb + tt * 136 + c0 + 8) = w1;
            { const bf16_t* gp_ = P.RG + (rowb + t0 + tt) * 2048 + cg0; gc0 = *(const u32x4*)gp_; gc1 = *(const u32x4*)(gp_ + 8); }
            if (chunk + 1 < T / 64) RG_LOAD(t0 + 64);
        }
        BAR_LDS();
#pragma unroll
        for (int mt = 0; mt < 4; ++mt) {
            f32x4 ar = {0.f, 0.f, 0.f, 0.f}, ai = {0.f, 0.f, 0.f, 0.f};
#pragma unroll
            for (int ks = 0; ks < 4; ++ks) { const bf16x8 A = *(const bf16x8*)(XCb + (16 * mt + r16) * 136 + 32 * ks + 8 * g);
                ar = mfma16(A, Ba[ks], ar); ai = mfma16(A, Bx[ks], ai); }
#pragma unroll
            for (int j = 0; j < 4; ++j) { const int tok = 16 * mt + 4 * g + j;
                const float r = fsigmoid(ar[j] + ba), ig = fsigmoid(ai[j] + bx);
                const float la = -sp8 * r;
                float a, m2;
                if (big) { a = __expf(la); m2 = 1.f - __expf(2.f * la); } else { a = 1.f + em1_poly(la); m2 = -em1_poly(2.f * la); }
                float mult = sqrtf(fmaxf(m2, 0.f)); if (t0 + tok == 0) mult = 1.f;
                LA[tok * 128 + ce] = a; LB[tok * 128 + ce] = mult * ig * XCf[tok * 128 + ce]; }
        }
        BAR_LDS();
        if (tid < 128) {
#pragma unroll 1
            for (int t16 = 0; t16 < 64; t16 += 16) { float av[16], bv[16];
#pragma unroll
                for (int e = 0; e < 16; ++e) { av[e] = LA[(t16 + e) * 128 + tid]; bv[e] = LB[(t16 + e) * 128 + tid]; }
#pragma unroll
                for (int e = 0; e < 16; ++e) { h = av[e] * h + bv[e]; LB[(t16 + e) * 128 + tid] = h; } }
        }
        BAR_LDS();
        {
            bf16_t* gp = P.RG + (rowb + t0 + tt) * 2048 + cg0;
            const float* hp = LB + tt * 128 + c0;
            u32x4 o0, o1;
            o0.x = cvt_pk_bf16(hp[0] * bflo(gc0.x), hp[1] * bfhi(gc0.x)); o0.y = cvt_pk_bf16(hp[2] * bflo(gc0.y), hp[3] * bfhi(gc0.y));
            o0.z = cvt_pk_bf16(hp[4] * bflo(gc0.z), hp[5] * bfhi(gc0.z)); o0.w = cvt_pk_bf16(hp[6] * bflo(gc0.w), hp[7] * bfhi(gc0.w));
            o1.x = cvt_pk_bf16(hp[8] * bflo(gc1.x), hp[9] * bfhi(gc1.x)); o1.y = cvt_pk_bf16(hp[10] * bflo(gc1.y), hp[11] * bfhi(gc1.y));
            o1.z = cvt_pk_bf16(hp[12] * bflo(gc1.z), hp[13] * bfhi(gc1.z)); o1.w = cvt_pk_bf16(hp[14] * bflo(gc1.w), hp[15] * bfhi(gc1.w));
            *(u32x4*)gp = o0; *(u32x4*)(gp + 8) = o1;
        }
    }
#undef RG_LOAD
    __syncthreads();
}

__device__ __forceinline__ unsigned f2key(float f) { const unsigned u = __builtin_bit_cast(unsigned, f); return (u & 0x80000000u) ? ~u : (u | 0x80000000u); }
__device__ __forceinline__ unsigned mbcnt64(unsigned long long m) { return __builtin_amdgcn_mbcnt_hi((unsigned)(m >> 32), __builtin_amdgcn_mbcnt_lo((unsigned)m, 0u)); }
__device__ __forceinline__ bf16x8 tr_read2(unsigned a0, unsigned a1) {
    s16x4 r0, r1;
    asm volatile("ds_read_b64_tr_b16 %0, %2\n\tds_read_b64_tr_b16 %1, %3\n\ts_waitcnt lgkmcnt(0)" : "=&v"(r0), "=&v"(r1) : "v"(a0), "v"(a1) : "memory");
    bf16x8 r; r[0] = r0[0]; r[1] = r0[1]; r[2] = r0[2]; r[3] = r0[3]; r[4] = r1[0]; r[5] = r1[1]; r[6] = r1[2]; r[7] = r1[3]; return r;
}
__device__ __forceinline__ void attn_item(const Ptrs& P, unsigned char* lds, int b, int tq0, int tid) {
    const int lane = tid & 63, w = __builtin_amdgcn_readfirstlane(tid >> 6), g = lane >> 4, r16 = lane & 15;
    constexpr int SP = 264;
    bf16_t* stg = (bf16_t*)lds;
    unsigned char* l2 = lds + 135168;
    unsigned short* sel = (unsigned short*)l2;
    unsigned* cntw = (unsigned*)(l2 + 2048);
    unsigned* gte = (unsigned*)(l2 + 2048 + 256);
    bf16_t* Pm = (bf16_t*)(l2 + 4096);
    const size_t rowb = (size_t)b * T;
    const int tmax = tq0 + 3;
    if (tmax < 256 || (DBG & 4)) {
        for (int i = tid; i < 1024; i += 512) sel[i] = (unsigned short)(((i & 255) <= tq0 + (i >> 8)) ? (i & 255) : 0);
        __syncthreads();
    } else {
        bf16x8 Aq[4][2]; f32x4 wq[4];
#pragma unroll
        for (int q = 0; q < 4; ++q) { const bf16_t* qp = P.QI + (rowb + tq0 + q) * 1024 + r16 * 64 + 8 * g; Aq[q][0] = *(const bf16x8*)qp; Aq[q][1] = *(const bf16x8*)(qp + 32);
            wq[q] = *(const f32x4*)(P.WI + (rowb + tq0 + q) * 16 + 4 * g); }
        unsigned* KB = (unsigned*)lds;
        const int nch = (tmax >> 6) + 1;
        const int ni = (w < nch) ? ((nch - w + 7) >> 3) : 0;
        bf16x8 Bk[4][2];
#define TILE_LOAD(SLOT, CC, TT) do { const bf16_t* kp = P.KI + (rowb + 64 * (CC) + 16 * (TT) + r16) * 64 + 8 * g; Bk[SLOT][0] = *(const bf16x8*)kp; Bk[SLOT][1] = *(const bf16x8*)(kp + 32); } while (0)
#define TILE_MATH(SLOT, TT) do { _Pragma("unroll") for (int q = 0; q < 4; ++q) { f32x4 a = {0.f, 0.f, 0.f, 0.f}; \
            a = mfma16(Aq[q][0], Bk[SLOT][0], a); a = mfma16(Aq[q][1], Bk[SLOT][1], a); \
            pv[q][TT] = wq[q][0] * fmaxf(a[0], 0.f) + wq[q][1] * fmaxf(a[1], 0.f) + wq[q][2] * fmaxf(a[2], 0.f) + wq[q][3] * fmaxf(a[3], 0.f); } } while (0)
        if (ni > 0) { TILE_LOAD(0, w, 0); TILE_LOAD(1, w, 1); }
#pragma unroll 1
        for (int it = 0; it < ni; ++it) {
            const int c = 8 * it + w; const bool more = it + 1 < ni;
            float pv[4][4], sv[4];
            TILE_LOAD(2, c, 2); TILE_MATH(0, 0);
            TILE_LOAD(3, c, 3); TILE_MATH(1, 1);
            if (more) TILE_LOAD(0, c + 8, 0);
            TILE_MATH(2, 2);
            if (more) TILE_LOAD(1, c + 8, 1);
            TILE_MATH(3, 3);
#pragma unroll
            for (int q = 0; q < 4; ++q) { float a0 = pv[q][0], b0 = pv[q][2], a1 = pv[q][1], b1 = pv[q][3];
                asm("s_nop 1\n\tv_permlane32_swap_b32 %0, %1" : "+v"(a0), "+v"(b0));
                asm("s_nop 1\n\tv_permlane32_swap_b32 %0, %1" : "+v"(a1), "+v"(b1));
                float x = a0 + b0, y = a1 + b1;
                asm("s_nop 1\n\tv_permlane16_swap_b32 %0, %1" : "+v"(x), "+v"(y));
                sv[q] = x + y; }
            const int s = 64 * c + lane;
#pragma unroll
            for (int q = 0; q < 4; ++q) KB[q * 8192 + s] = (s <= tq0 + q) ? f2key(sv[q]) : 0u;
        }
#undef TILE_LOAD
#undef TILE_MATH
        __syncthreads();
        const int qs = w >> 1, hs = w & 1;
        unsigned k2[64];
#pragma unroll
        for (int r = 0; r < 64; ++r) k2[r] = KB[qs * 8192 + 64 * (2 * r + hs) + lane];
        __syncthreads();
#pragma unroll
        for (int r = 0; r < 64; ++r) k2[r] = (2 * r + hs < nch) ? k2[r] : 0u;
        const int nact = (nch + 1 - hs) >> 1;
        volatile unsigned* xw = (volatile unsigned*)(lds + 147456);
        const unsigned seq = (xw[32 + w] + 1u) & 0xffu; if (lane == 0) xw[32 + w] = seq;
#define PAIR_XCHG(SLOT, TAG, MINE, OTHER) do { const unsigned tg_ = (seq << 8) | (unsigned)(TAG); if (lane == 0) xw[w * 4 + (SLOT)] = ((MINE) << 16) | tg_; \
            unsigned v_; do { v_ = xw[(w ^ 1) * 4 + (SLOT)]; } while ((v_ & 0xffffu) != tg_); OTHER = v_ >> 16; } while (0)
        unsigned th = 0u;
        for (int bit = 31; bit >= 0; --bit) {
            const unsigned cand = th | (1u << bit); unsigned cnt = 0, oth;
#pragma unroll
            for (int k = 0; k < 4; ++k) if (16 * k < nact) {
#pragma unroll
                for (int r = 16 * k; r < 16 * k + 16; ++r) cnt += (unsigned)__popcll(__ballot(k2[r] >= cand)); }
            PAIR_XCHG(bit & 1, 1 + bit, cnt, oth);
            cnt += oth;
            if (cnt >= 256u) th = cand;
            if (cnt == 256u) break;
        }
        unsigned cg = 0, ce = 0;
#pragma unroll
        for (int k = 0; k < 4; ++k) if (16 * k < nact) {
#pragma unroll
            for (int r = 16 * k; r < 16 * k + 16; ++r) { cg += (k2[r] > th) ? 1u : 0u; ce += (k2[r] == th) ? 1u : 0u; } }
        const unsigned ig = wave_incl_scan(cg, lane), ie = wave_incl_scan(ce, lane);
        const unsigned ngt = (unsigned)__builtin_amdgcn_readlane((int)ig, 63), neq = (unsigned)__builtin_amdgcn_readlane((int)ie, 63);
        unsigned ogt, oeq;
        PAIR_XCHG(2, 40, ngt, ogt); PAIR_XCHG(3, 41, neq, oeq);
        const unsigned tot_gt = ngt + ogt, quota = 256u - tot_gt;
        unsigned pos_g = (hs ? ogt : 0u) + ig - cg, pos_e = (hs ? oeq : 0u) + ie - ce;
        const bool any_eq = (neq + oeq) != 0u;
#pragma unroll
        for (int k = 0; k < 4; ++k) if (16 * k < nact) {
#pragma unroll
            for (int r = 16 * k; r < 16 * k + 16; ++r) { const unsigned short idx = (unsigned short)(64 * (2 * r + hs) + lane);
                if (k2[r] > th) { sel[qs * 256 + pos_g] = idx; ++pos_g; }
                if (any_eq) { if (k2[r] == th) { if (pos_e < quota) sel[qs * 256 + tot_gt + pos_e] = idx; ++pos_e; } } } }
        { unsigned dn_; PAIR_XCHG(0, 42, 0u, dn_); (void)dn_; }
#undef PAIR_XCHG
    }
    const int q = w >> 1, half = w & 1, tq = tq0 + q;
    const int nsel = tq + 1 < 256 ? tq + 1 : 256;
    bf16x8 Af[8];
    {
        const bf16_t* qlp = P.QL + (rowb + tq) * 4096 + r16 * 256 + 8 * g;
#pragma unroll
        for (int ks = 0; ks < 8; ++ks) Af[ks] = *(const bf16x8*)(qlp + 32 * ks);
    }
    bf16_t* stw = stg + w * 32 * SP;
    bf16_t* Pw = (bf16_t*)(l2 + 2048) + w * 16 * 40;
    volatile unsigned* xa = (volatile unsigned*)(lds + 147456);
    const unsigned aseq = (xa[40 + w] + 1u) & 0xffffu; if (lane == 0) xa[40 + w] = aseq;
    float mrun[4], lrun[4];
#pragma unroll
    for (int j = 0; j < 4; ++j) { mrun[j] = -1e30f; lrun[j] = 0.f; }
    f32x4 oacc[16];
#pragma unroll
    for (int dt = 0; dt < 16; ++dt) oacc[dt] = (f32x4){0.f, 0.f, 0.f, 0.f};
    const int qq = r16 >> 2, pp4 = lane & 3;
    const unsigned tr_base = (unsigned)(uintptr_t)stw + (unsigned)(((8 * g + qq) * SP + 4 * pp4) * 2);
    const int slot0 = 128 * half;
#define STG_LOAD(CK) do { _Pragma("unroll") for (int it = 0; it < 16; ++it) { const int pp = it * 64 + lane, kk = pp >> 5, cp = pp & 31; \
        const int idx = (int)sel[q * 256 + slot0 + 32 * (CK) + kk]; stv[it] = *(const u32x4*)(P.CKV + (rowb + idx) * 256 + 8 * cp); } } while (0)
#define TR8(R, OFF) asm volatile( \
            "ds_read_b64_tr_b16 %0, %8 offset:" #OFF "+0\n\tds_read_b64_tr_b16 %1, %8 offset:" #OFF "+2112\n\t" \
            "ds_read_b64_tr_b16 %2, %8 offset:" #OFF "+32\n\tds_read_b64_tr_b16 %3, %8 offset:" #OFF "+2144\n\t" \
            "ds_read_b64_tr_b16 %4, %8 offset:" #OFF "+64\n\tds_read_b64_tr_b16 %5, %8 offset:" #OFF "+2176\n\t" \
            "ds_read_b64_tr_b16 %6, %8 offset:" #OFF "+96\n\tds_read_b64_tr_b16 %7, %8 offset:" #OFF "+2208\n\t" \
            "s_waitcnt lgkmcnt(0)" \
            : "=&v"(R[0]), "=&v"(R[1]), "=&v"(R[2]), "=&v"(R[3]), "=&v"(R[4]), "=&v"(R[5]), "=&v"(R[6]), "=&v"(R[7]) \
            : "v"(tr_base) : "memory")
    u32x4 stv[16];
    STG_LOAD(0);
#pragma unroll 1
    for (int ck = 0; ck < 4; ++ck) {
#pragma unroll
        for (int it = 0; it < 16; ++it) { const int pp = it * 64 + lane, kk = pp >> 5, cp = pp & 31; *(u32x4*)(stw + kk * SP + 8 * cp) = stv[it]; }
        if (ck < 3) STG_LOAD(ck + 1);
        asm volatile("s_waitcnt lgkmcnt(0)" ::: "memory");
        f32x4 sc[2];
#pragma unroll
        for (int k2 = 0; k2 < 2; ++k2) {
            const int slot = slot0 + 32 * ck + 16 * k2 + r16; const bool valid = slot < nsel; const int idx = (int)sel[q * 256 + slot];
            int dist = tq - idx; dist = dist > 128 ? 128 : dist; dist = dist < 0 ? 0 : dist;
            const f32x4 bb = *(const f32x4*)(P.BT + dist * 16 + 4 * g);
            const bf16_t* kp = stw + (16 * k2 + r16) * SP + 8 * g;
            f32x4 a = {0.f, 0.f, 0.f, 0.f};
#pragma unroll
            for (int ks = 0; ks < 8; ++ks) a = mfma16(Af[ks], *(const bf16x8*)(kp + 32 * ks), a);
#pragma unroll
            for (int j = 0; j < 4; ++j) a[j] = valid ? a[j] * 0.0625f + bb[j] : -1e30f;
            sc[k2] = a;
        }
#pragma unroll
        for (int j = 0; j < 4; ++j) {
            const float mn = fmaxf(mrun[j], row16_max(fmaxf(sc[0][j], sc[1][j])));
            const float scale = __expf(mrun[j] - mn);
            const float p0 = __expf(sc[0][j] - mn), p1 = __expf(sc[1][j] - mn);
            lrun[j] = lrun[j] * scale + row16_sum(p0 + p1);
            mrun[j] = mn;
#pragma unroll
            for (int dt = 0; dt < 16; ++dt) oacc[dt][j] *= scale;
            Pw[(4 * g + j) * 40 + r16] = (bf16_t)(cvt_pk_bf16(p0, 0.f) & 0xffffu);
            Pw[(4 * g + j) * 40 + 16 + r16] = (bf16_t)(cvt_pk_bf16(p1, 0.f) & 0xffffu);
        }
        asm volatile("s_waitcnt lgkmcnt(0)" ::: "memory");
        const bf16x8 Ap = *(const bf16x8*)(Pw + r16 * 40 + 8 * g);
#pragma unroll
        for (int hh = 0; hh < 4; ++hh) {
            s16x4 r[8];
            if (hh == 0) TR8(r, 0); else if (hh == 1) TR8(r, 128); else if (hh == 2) TR8(r, 256); else TR8(r, 384);
#pragma unroll
            for (int dt = 0; dt < 4; ++dt) { bf16x8 Bv; Bv[0] = r[2 * dt][0]; Bv[1] = r[2 * dt][1]; Bv[2] = r[2 * dt][2]; Bv[3] = r[2 * dt][3];
                Bv[4] = r[2 * dt + 1][0]; Bv[5] = r[2 * dt + 1][1]; Bv[6] = r[2 * dt + 1][2]; Bv[7] = r[2 * dt + 1][3];
                oacc[4 * hh + dt] = mfma16(Ap, Bv, oacc[4 * hh + dt]); }
        }
    }
#undef STG_LOAD
#undef TR8
    {
        float* cmb = (float*)stw;
#pragma unroll
        for (int dt = 0; dt < 8; ++dt)
#pragma unroll
            for (int j = 0; j < 4; ++j) cmb[(dt * 4 + j) * 64 + lane] = half ? oacc[dt][j] : oacc[8 + dt][j];
#pragma unroll
        for (int j = 0; j < 4; ++j) { cmb[2048 + j * 64 + lane] = mrun[j]; cmb[2304 + j * 64 + lane] = lrun[j]; }
        asm volatile("s_waitcnt lgkmcnt(0)" ::: "memory");
        if (lane == 0) xa[48 + w] = aseq;
        while (xa[48 + (w ^ 1)] != aseq) { }
        const float* pc = (const float*)(stg + (w ^ 1) * 32 * SP);
        float wa[4], wb[4];
#pragma unroll
        for (int j = 0; j < 4; ++j) { const float mo = pc[2048 + j * 64 + lane], lo = pc[2304 + j * 64 + lane];
            const float mm = fmaxf(mrun[j], mo); const float ea = __expf(mrun[j] - mm), eb = __expf(mo - mm);
            const float inv = 1.f / (lrun[j] * ea + lo * eb); wa[j] = ea * inv; wb[j] = eb * inv; }
        bf16_t* op = P.QL + (rowb + tq) * 4096;
#pragma unroll
        for (int dt = 0; dt < 8; ++dt)
#pragma unroll
            for (int j = 0; j < 4; ++j) { const float v = (half ? oacc[8 + dt][j] : oacc[dt][j]) * wa[j] + pc[(dt * 4 + j) * 64 + lane] * wb[j];
                op[(4 * g + j) * 256 + 16 * (8 * half + dt) + r16] = (bf16_t)(cvt_pk_bf16(v, 0.f) & 0xffffu); }
    }
}

__device__ __forceinline__ void ln_rows(const Ptrs& P, int tid, int G) {
    const int lane = tid & 63, gw = blockIdx.x * 8 + (tid >> 6), NGW = G * 8;
    f32x4 gg[8], bb[8];
#pragma unroll
    for (int j = 0; j < 8; ++j) { gg[j] = *(const f32x4*)(P.ln_g + 4 * lane + 256 * j); bb[j] = *(const f32x4*)(P.ln_b + 4 * lane + 256 * j); }
    for (int m = gw; m < M; m += 2 * NGW) {
        const int m1 = m + NGW; const bool two = m1 < M;
        float* y0 = P.out + (size_t)(M - 1 - m) * D + 4 * lane; float* y1 = P.out + (size_t)(M - 1 - (two ? m1 : m)) * D + 4 * lane;
        f32x4 v[8], u[8]; float s = 0.f, t = 0.f;
#pragma unroll
        for (int j = 0; j < 8; ++j) { v[j] = *(const f32x4*)(y0 + 256 * j); u[j] = *(const f32x4*)(y1 + 256 * j); }
#pragma unroll
        for (int j = 0; j < 8; ++j) { s += (v[j][0] + v[j][1]) + (v[j][2] + v[j][3]); t += (u[j][0] + u[j][1]) + (u[j][2] + u[j][3]); }
        s = rows4_sum(row16_sum(s)); t = rows4_sum(row16_sum(t));
        const float mean0 = s * (1.f / D), mean1 = t * (1.f / D); float s2 = 0.f, t2 = 0.f;
#pragma unroll
        for (int j = 0; j < 8; ++j) { v[j] = v[j] - mean0; u[j] = u[j] - mean1;
            s2 += (v[j][0] * v[j][0] + v[j][1] * v[j][1]) + (v[j][2] * v[j][2] + v[j][3] * v[j][3]);
            t2 += (u[j][0] * u[j][0] + u[j][1] * u[j][1]) + (u[j][2] * u[j][2] + u[j][3] * u[j][3]); }
        s2 = rows4_sum(row16_sum(s2)); t2 = rows4_sum(row16_sum(t2));
        const float rstd0 = 1.f / sqrtf(s2 * (1.f / D) + LN_EPS), rstd1 = 1.f / sqrtf(t2 * (1.f / D) + LN_EPS);
#pragma unroll
        for (int j = 0; j < 8; ++j) *(f32x4*)(y0 + 256 * j) = v[j] * rstd0 * gg[j] + bb[j];
        if (two) {
#pragma unroll
            for (int j = 0; j < 8; ++j) *(f32x4*)(y1 + 256 * j) = u[j] * rstd1 * gg[j] + bb[j]; }
    }
}

struct Args { const float* in[17]; float* out; unsigned char* ws; int ph_lo, ph_hi; };
constexpr int NPH = 7;

__global__ void __launch_bounds__(512, 2) mega_fwd(Args args) {
    extern __shared__ __attribute__((aligned(16))) unsigned char lds[];
    cg::grid_group grid = cg::this_grid();
    const int tid = threadIdx.x, G = gridDim.x;
    Ptrs P;
    P.x = args.in[0]; P.w_in = args.in[1]; P.kvg = args.in[2]; P.w_uv = args.in[3]; P.w_a = args.in[4]; P.conv_w = args.in[5]; P.conv_b = args.in[6];
    P.wga = args.in[7]; P.bga = args.in[8]; P.wgx = args.in[9]; P.bgx = args.in[10]; P.lam = args.in[11]; P.w_b = args.in[12]; P.relb = args.in[13];
    P.w_o = args.in[14]; P.ln_g = args.in[15]; P.ln_b = args.in[16]; P.out = args.out; P.ws = args.ws;
    unsigned char* ws = args.ws;
    P.WinT = (bf16_t*)(ws + WS_WIN); P.WuvT = (bf16_t*)(ws + WS_WUV); P.WaT = (bf16_t*)(ws + WS_WA); P.WbT = (bf16_t*)(ws + WS_WB); P.WoT = (bf16_t*)(ws + WS_WO);
    P.WgaT = (bf16_t*)(ws + WS_WGA); P.WgxT = (bf16_t*)(ws + WS_WGX); P.QL = (bf16_t*)(ws + WS_QL); P.CKV = (bf16_t*)(ws + WS_CKV); P.AG = (bf16_t*)(ws + WS_AG);
    P.QI = (bf16_t*)(ws + WS_QI); P.KI = (bf16_t*)(ws + WS_KI); P.XR = (bf16_t*)(ws + WS_XR); P.RG = (bf16_t*)(ws + WS_RG); P.GB = (bf16_t*)(ws + WS_GB);
    P.XB = (bf16_t*)args.out; P.GA = (bf16_t*)args.out + (size_t)M * D;
    P.WI = (float*)(ws + WS_WI); P.CKVF = (float*)(ws + WS_CKVF); P.BT = (float*)(ws + WS_BT);
    unsigned* ctl = (unsigned*)(ws + WS_CTL);
    PG8_LAS unsigned char* ldsl = (PG8_LAS unsigned char*)lds;
    const int lo = args.ph_lo, hi = args.ph_hi;
#define IN(k) (lo <= (k) && (k) < hi)
#define SEAM(k) do { if (IN(k) && IN((k) + 1)) grid.sync(); } while (0)

    if (IN(0)) { if (blockIdx.x == 0 && tid < 4) ctl[64 * tid] = 0u; p0_prologue(P, lds, tid, G); }
    SEAM(0);
    if (IN(1)) {
        pg8::Gemm g{P.XB, P.WinT, 2048, 2048, 2048, 0}; pg8::StaticOrder S; S.init(M, NP, G, (int)blockIdx.x);
        EpiProj E{P};
        pg8::gemm_phase<EpiProj>(ldsl, g, S, E);
        pg8::Unit u;
        for (int i = 0; S.next(i, u); ++i) if (u.pn == 16) ckv_norm_rows(P, u.pm * 256, 256, tid);
    }
    SEAM(1);
    if (IN(2) && !(DBG & 1)) {
        if (blockIdx.x < 64) rglru_item(P, lds, (int)blockIdx.x >> 4, (int)blockIdx.x & 15, tid);
        if (tid < 64) ((volatile unsigned*)(lds + 147456))[tid] = 0u;
        __syncthreads();
        const int hb = ((int)blockIdx.x & 7) >> 1;
        for (int k = 0; k < NB; ++k) {
            const int b = (hb + k) & 3;
            for (;;) {
                __syncthreads();
                if (tid == 0) *(volatile int*)(lds + 147712) = (int)atomicAdd(ctl + 64 * b, 1u);
                __syncthreads();
                const int item = *(volatile int*)(lds + 147712);
                if (item >= T / 4) break;
                attn_item(P, lds, b, 4 * ((T / 4 - 1) - item), tid);
            }
        }
    }
    SEAM(2);
    if (IN(3)) {
        pg8::Gemm g{P.QL, P.WuvT, 512, 4096, 512, 512}; pg8::StaticOrder S; S.init(M, 2048, G, (int)blockIdx.x);
        EpiGate<0> E{P.AG, nullptr};
        pg8::gemm_phase<EpiGate<0>, true>(ldsl, g, S, E);
    }
    SEAM(3);
    if (IN(4)) {
        pg8::StaticOrder S; S.init(M, 2048, G, (int)blockIdx.x);
        { pg8::Gemm g{P.AG, P.WaT, 2048, 2048, 2048, 0}; EpiGate<1> E{P.XR, P.GA}; pg8::gemm_phase<EpiGate<1>>(ldsl, g, S, E); }
        { pg8::Gemm g{P.RG, P.WbT, 2048, 2048, 2048, 0}; EpiGate<2> E{P.XR, P.GB}; pg8::gemm_phase<EpiGate<2>>(ldsl, g, S, E); }
    }
    SEAM(4);
    if (IN(5)) {
        pg8::Gemm g{P.XR, P.WoT, 2048, 2048, 2048, 0}; pg8::StaticOrder S; S.init(M, 2048, G, (int)blockIdx.x);
        EpiOut E{P.x, P.out};
        pg8::gemm_phase<EpiOut>(ldsl, g, S, E);
    }
    SEAM(5);
    if (IN(6)) { ln_rows(P, tid, G); }
#undef IN
#undef SEAM
}

extern "C" void kernel_launch(void* const* d_in, const int* in_sizes, int n_in, void* d_out, int out_size, void* d_ws, size_t ws_size, hipStream_t stream) {
    static int grid = 0;
    if (grid == 0) {
        if (n_in != 17 || out_size != M * D || ws_size < WS_END) { fprintf(stderr, "kernel_launch: unexpected shapes (n_in %d out %d ws %zu)\n", n_in, out_size, ws_size); grid = -1; return; }
        int dev = 0, cus = 0, per_cu = 0;
        hipGetDevice(&dev); hipDeviceGetAttribute(&cus, hipDeviceAttributeMultiprocessorCount, dev);
        if (hipFuncSetAttribute((const void*)mega_fwd, hipFuncAttributeMaxDynamicSharedMemorySize, LDS_BYTES) != hipSuccess) { fprintf(stderr, "kernel_launch: hipFuncSetAttribute failed\n"); grid = -1; return; }
        if (hipOccupancyMaxActiveBlocksPerMultiprocessor(&per_cu, (const void*)mega_fwd, 512, LDS_BYTES) != hipSuccess || per_cu < 1) { fprintf(stderr, "kernel_launch: occupancy query says %d\n", per_cu); per_cu = 1; }
        (void)hipGetLastError();
        grid = cus * per_cu;
    }
    if (grid < 0) return;
    Args a{};
    for (int i = 0; i < 17; ++i) a.in[i] = (const float*)d_in[i];
    a.out = (float*)d_out; a.ws = (unsigned char*)d_ws;
#if N_LAUNCHES == 1
    a.ph_lo = 0; a.ph_hi = NPH;
    void* kargs[] = {&a};
    hipError_t e = hipLaunchCooperativeKernel((const void*)mega_fwd, dim3(grid), dim3(512), kargs, LDS_BYTES, stream);
    if (e != hipSuccess) fprintf(stderr, "cooperative launch failed: %s (grid %d)\n", hipGetErrorString(e), grid);
#else
    for (int ph = 0; ph < NPH; ++ph) { a.ph_lo = ph; a.ph_hi = ph + 1;
        hipLaunchKernelGGL(mega_fwd, dim3(grid), dim3(512), LDS_BYTES, stream, a); }
#endif
}
```

```cpp
#include <hip/hip_runtime.h>
#include <hip/hip_cooperative_groups.h>
#include <cstdio>
#include <cstdint>
namespace cg = cooperative_groups;

#ifndef DBG
#define DBG 0
#endif
#ifndef N_LAUNCHES
#define N_LAUNCHES 1
#endif

namespace pg8 {
#define PG8_LAS __attribute__((address_space(3)))
typedef unsigned short bf16_t;
typedef short bf16x8 __attribute__((ext_vector_type(8)));
typedef float f32x4 __attribute__((ext_vector_type(4)));
typedef unsigned u32x4 __attribute__((ext_vector_type(4)));
constexpr int BM = 256, BK = 64, HALF = 128, HTB = HALF * BK * 2, STAGE_BYTES = 8 * HTB, NXCD = 8, WGM = 4;

__host__ __device__ __forceinline__ int lds_byte(int r, int c) { const int st = (r >> 4) * 2 + (c >> 5), rr = r & 15, cc = c & 31, ob = rr * 64 + cc * 2; return st * 1024 + (ob ^ (((ob >> 9) & 1) << 5)); }
__host__ __device__ __forceinline__ void stage_rc(int b, int& R, int& C) { const int st = b / 1024, sb = b % 1024, swz = sb ^ (((sb >> 9) & 1) << 5); R = (st >> 1) * 16 + swz / 64; C = (st & 1) * 32 + (swz % 64) / 2; }
__host__ __device__ __forceinline__ int perm32(int rho) { const int n = rho >> 4, i = rho & 15; return 8 * (i >> 2) + 4 * n + (i & 3); }

struct Unit { int pm, pn; };
struct Gemm { const bf16_t* A; const bf16_t* Bt; int K, lda, ldb, apn; };

struct StaticOrder {
    int nM, nN, nwg, G, c;
    __host__ __device__ __forceinline__ void init(int M, int N, int G_, int c_) { nM = M / BM; nN = N / BM; nwg = nM * nN; G = G_; c = c_; }
    __host__ __device__ __forceinline__ bool next(int i, Unit& u) const {
        const long L = (long)i * G + c; if (L >= nwg) return false;
        int wgid = (int)L; { const int q = nwg / NXCD, r = nwg % NXCD, xcd = wgid % NXCD, off = wgid / NXCD; wgid = (xcd < r ? xcd * (q + 1) : r * (q + 1) + (xcd - r) * q) + off; }
        const int nig = WGM * nN, gid = wgid / nig, fm = gid * WGM, gsz = (nM - fm) < WGM ? (nM - fm) : WGM;
        u.pm = fm + ((wgid % nig) % gsz); u.pn = (wgid % nig) / gsz; return true;
    }
};

__device__ __forceinline__ unsigned cvt_pk_bf16(float lo, float hi) { unsigned r; asm volatile("v_cvt_pk_bf16_f32 %0, %1, %2" : "=v"(r) : "v"(lo), "v"(hi)); return r; }

template <class Epi, bool BLKDIAG = false>
__device__ __forceinline__ void gemm_phase(PG8_LAS unsigned char* lds, const Gemm g, const StaticOrder& S, const Epi& E) {
    const int tid = threadIdx.x, wid = __builtin_amdgcn_readfirstlane(tid >> 6), lane = tid & 63, wr = wid >> 2, wc = wid & 3, fr = lane & 15, fq = lane >> 4;
    const int K = g.K, nt = K / BK;
    unsigned voffA[2], voffB[2];
#pragma unroll
    for (int i = 0; i < 2; ++i) { int R, C; stage_rc(tid * 16 + i * 8192, R, C); const int Rb = (R & ~31) + perm32(R & 31);
        voffA[i] = (unsigned)(R * g.lda + C) * 2u; voffB[i] = (unsigned)(Rb * g.ldb + C) * 2u; }
    const size_t kstep = (size_t)(BK * 2);
    const size_t hstepA = (size_t)HALF * g.lda * 2, hstepB = (size_t)HALF * g.ldb * 2;
    const size_t tstepA = 2 * hstepA, tstepB = 2 * hstepB;
    const unsigned ldsw = (unsigned)wid * 1024u;
    const int aoff = lds_byte(wr * 64 + fr, fq * 8), boff = lds_byte(wc * 32 + fr, fq * 8);
#define PG8_SA(b, h) (((b) * 2 + (h)) * HTB)
#define PG8_SB(b, h) ((4 + (b) * 2 + (h)) * HTB)
#define PG8_STAGE(bufoff, gbase, voff) do { _Pragma("unroll") for (int _i = 0; _i < 2; ++_i) \
        __builtin_amdgcn_global_load_lds((const unsigned*)((const char*)(gbase) + (voff)[_i]), (PG8_LAS unsigned*)(lds + (bufoff) + ldsw + _i * 8192), 16, 0, 0); } while (0)
#define PG8_LDA(dst, b, h) do { _Pragma("unroll") for (int m = 0; m < 4; ++m) _Pragma("unroll") for (int k = 0; k < 2; ++k) dst[m][k] = *(const PG8_LAS bf16x8*)(lds + PG8_SA(b, h) + aoff + m * 2048 + k * 1024); } while (0)
#define PG8_LDB(dst, b, h) do { _Pragma("unroll") for (int n = 0; n < 2; ++n) _Pragma("unroll") for (int k = 0; k < 2; ++k) dst[n][k] = *(const PG8_LAS bf16x8*)(lds + PG8_SB(b, h) + boff + n * 2048 + k * 1024); } while (0)
#define PG8_MMA(ai, bj, At, Bt) do { __builtin_amdgcn_s_setprio(1); _Pragma("unroll") for (int m = 0; m < 4; ++m) _Pragma("unroll") for (int n = 0; n < 2; ++n) _Pragma("unroll") for (int k = 0; k < 2; ++k) \
        acc[ai][bj][m][n] = __builtin_amdgcn_mfma_f32_16x16x32_bf16(Bt[n][k], At[m][k], acc[ai][bj][m][n], 0, 0, 0); __builtin_amdgcn_s_setprio(0); } while (0)
#define PG8_WAIT_V(n) asm volatile("s_waitcnt vmcnt(" #n ")" ::: "memory")
#define PG8_WAIT_L(n) asm volatile("s_waitcnt lgkmcnt(" #n ")" ::: "memory")
#define PG8_BAR __builtin_amdgcn_s_barrier()
#define PG8_SCHED __builtin_amdgcn_sched_barrier(0)
    Unit cur, nxt; int ui = 0;
    if (!S.next(0, cur)) return;
    f32x4 acc[2][2][4][2];
#pragma unroll
    for (int a = 0; a < 2; ++a)
#pragma unroll
        for (int b = 0; b < 2; ++b)
#pragma unroll
            for (int m = 0; m < 4; ++m)
#pragma unroll
                for (int n = 0; n < 2; ++n) acc[a][b][m][n] = (f32x4){0.f, 0.f, 0.f, 0.f};
    bf16x8 At[4][2], B0[2][2], B1[2][2];
    const char* cA = (const char*)g.A + (size_t)cur.pm * tstepA + (size_t)cur.pn * g.apn * 2; const char* cB = (const char*)g.Bt + (size_t)cur.pn * tstepB;
    PG8_STAGE(PG8_SB(0, 0), cB, voffB); PG8_STAGE(PG8_SB(0, 1), cB + hstepB, voffB); PG8_STAGE(PG8_SA(0, 0), cA, voffA); PG8_STAGE(PG8_SA(0, 1), cA + hstepA, voffA);
    if (wr == 1) PG8_BAR;
    PG8_WAIT_V(2); PG8_BAR;
    PG8_STAGE(PG8_SB(1, 0), cB + kstep, voffB); PG8_STAGE(PG8_SA(1, 0), cA + kstep, voffA); PG8_STAGE(PG8_SB(1, 1), cB + hstepB + kstep, voffB);
    PG8_WAIT_V(6); PG8_BAR;
    for (;;) {
        const bool has_next = S.next(ui + 1, nxt);
        const char* nA = has_next ? (const char*)g.A + (size_t)nxt.pm * tstepA + (size_t)nxt.pn * g.apn * 2 : cA; const char* nB = has_next ? (const char*)g.Bt + (size_t)nxt.pn * tstepB : cB;
        for (int t = 0; t < nt; t += 2) {
            const bool last = (t == nt - 2);
            const bool lo_ = BLKDIAG ? (t < nt / 2) : true, hi_ = BLKDIAG ? !lo_ : true;
            const char* a1 = cA + (size_t)(t + 1) * kstep;
            const char* a2 = last ? nA : cA + (size_t)(t + 2) * kstep; const char* b2 = last ? nB : cB + (size_t)(t + 2) * kstep;
            const char* a3 = a2 + kstep; const char* b3 = b2 + kstep;
            PG8_LDB(B0, 0, 0); PG8_LDB(B1, 0, 1); PG8_SCHED; PG8_LDA(At, 0, 0); PG8_STAGE(PG8_SA(1, 1), a1 + hstepA, voffA);
            PG8_WAIT_V(8); PG8_WAIT_L(0); PG8_BAR; if (lo_) PG8_MMA(0, 0, At, B0); if (hi_) PG8_MMA(0, 1, At, B1); PG8_BAR; PG8_SCHED;
            PG8_LDA(At, 0, 1); PG8_STAGE(PG8_SB(0, 0), b2, voffB); PG8_STAGE(PG8_SB(0, 1), b2 + hstepB, voffB); PG8_STAGE(PG8_SA(0, 0), a2, voffA);
            PG8_WAIT_V(8); PG8_WAIT_L(0); PG8_BAR; if (lo_) PG8_MMA(1, 0, At, B0); if (hi_) PG8_MMA(1, 1, At, B1); PG8_BAR; PG8_SCHED;
            PG8_LDB(B0, 1, 0); PG8_LDB(B1, 1, 1); PG8_SCHED; PG8_LDA(At, 1, 0); PG8_STAGE(PG8_SA(0, 1), a2 + hstepA, voffA);
            PG8_WAIT_V(8); PG8_WAIT_L(0); PG8_BAR; if (lo_) PG8_MMA(0, 0, At, B0); if (hi_) PG8_MMA(0, 1, At, B1); PG8_BAR; PG8_SCHED;
            PG8_LDA(At, 1, 1); PG8_STAGE(PG8_SB(1, 0), b3, voffB); PG8_STAGE(PG8_SB(1, 1), b3 + hstepB, voffB); PG8_STAGE(PG8_SA(1, 0), a3, voffA);
            PG8_WAIT_V(8); PG8_WAIT_L(0); PG8_BAR; if (lo_) PG8_MMA(1, 0, At, B0); if (hi_) PG8_MMA(1, 1, At, B1); PG8_BAR; PG8_SCHED;
        }
        if (wr == 0) PG8_BAR;
        E(acc, cur, wr, wc, fr, fq);
        if (!has_next) break;
#pragma unroll
        for (int a = 0; a < 2; ++a)
#pragma unroll
            for (int b = 0; b < 2; ++b)
#pragma unroll
                for (int m = 0; m < 4; ++m)
#pragma unroll
                    for (int n = 0; n < 2; ++n) acc[a][b][m][n] = (f32x4){0.f, 0.f, 0.f, 0.f};
        cur = nxt; cA = nA; cB = nB; ++ui;
        if (wr == 1) PG8_BAR;
    }
    PG8_WAIT_V(0);
    PG8_BAR;
#undef PG8_SA
#undef PG8_SB
#undef PG8_STAGE
#undef PG8_LDA
#undef PG8_LDB
#undef PG8_MMA
#undef PG8_WAIT_V
#undef PG8_WAIT_L
#undef PG8_BAR
#undef PG8_SCHED
}
}

using pg8::bf16_t; using pg8::bf16x8; using pg8::f32x4; using pg8::u32x4; using pg8::cvt_pk_bf16;
typedef short s16x4 __attribute__((ext_vector_type(4)));
__device__ __forceinline__ f32x4 mfma16(bf16x8 a, bf16x8 b, f32x4 c) { const f32x4 r = __builtin_amdgcn_mfma_f32_16x16x32_bf16(a, b, c, 0, 0, 0); asm volatile("" :: "v"(a), "v"(b)); return r; }
#define LAS __attribute__((address_space(3)))

constexpr int NB = 4, T = 8192, D = 2048, M = NB * T;
constexpr int NP = 15872;
constexpr float LN_EPS = 1e-5f;
constexpr float ALPHA = 1.189207115002721f;
constexpr size_t MiB = 1u << 20;
constexpr size_t WS_CTL = 0;
constexpr size_t WS_BT = 1 * MiB;
constexpr size_t WS_WIN = 2 * MiB;
constexpr size_t WS_WUV = 64 * MiB;
constexpr size_t WS_WA = 66 * MiB, WS_WB = 74 * MiB, WS_WO = 82 * MiB;
constexpr size_t WS_WGA = 90 * MiB, WS_WGX = 90 * MiB + 512 * 1024;
constexpr size_t WS_QL = 96 * MiB;
constexpr size_t WS_CKV = 352 * MiB;
constexpr size_t WS_AG = 368 * MiB;
constexpr size_t WS_QI = 496 * MiB;
constexpr size_t WS_KI = 560 * MiB;
constexpr size_t WS_WI = 564 * MiB;
constexpr size_t WS_XR = 568 * MiB;
constexpr size_t WS_RG = 696 * MiB;
constexpr size_t WS_GB = 824 * MiB;
constexpr size_t WS_CKVF = 952 * MiB;
constexpr size_t WS_END = 984 * MiB;
constexpr int LDS_BYTES = 151552;

__device__ __forceinline__ float shfl_xor_safe(float v, int m) { float r = __shfl_xor(v, m); asm volatile("s_waitcnt lgkmcnt(0)" : "+v"(r)); return r; }
__device__ __forceinline__ void lgkm_fence4(float& a, float& b, float& c, float& d) { asm volatile("s_waitcnt lgkmcnt(0)" : "+v"(a), "+v"(b), "+v"(c), "+v"(d)); }
template <int CTRL> __device__ __forceinline__ float dpp_f(float v) { return __builtin_bit_cast(float, __builtin_amdgcn_update_dpp(0, __builtin_bit_cast(int, v), CTRL, 0xf, 0xf, true)); }
__device__ __forceinline__ float row16_sum(float v) { v += dpp_f<0x121>(v); v += dpp_f<0x122>(v); v += dpp_f<0x124>(v); v += dpp_f<0x128>(v); return v; }
__device__ __forceinline__ float row16_max(float v) { v = fmaxf(v, dpp_f<0x121>(v)); v = fmaxf(v, dpp_f<0x122>(v)); v = fmaxf(v, dpp_f<0x124>(v)); v = fmaxf(v, dpp_f<0x128>(v)); return v; }
__device__ __forceinline__ float rows4_sum(float v) {
    float a = v, b = v;
    asm("s_nop 1\n\tv_permlane32_swap_b32 %0, %1" : "+v"(a), "+v"(b));
    float s = a + b, t = s;
    asm("s_nop 1\n\tv_permlane16_swap_b32 %0, %1" : "+v"(s), "+v"(t));
    return s + t; }
template <int CTRL> __device__ __forceinline__ unsigned dpp_u(unsigned v) { return (unsigned)__builtin_amdgcn_update_dpp(0, (int)v, CTRL, 0xf, 0xf, true); }
__device__ __forceinline__ unsigned wave_incl_scan(unsigned v, int lane) {
    v += dpp_u<0x111>(v); v += dpp_u<0x112>(v); v += dpp_u<0x114>(v); v += dpp_u<0x118>(v);
    const unsigned r0 = (unsigned)__builtin_amdgcn_readlane((int)v, 15), r1 = (unsigned)__builtin_amdgcn_readlane((int)v, 31), r2 = (unsigned)__builtin_amdgcn_readlane((int)v, 47);
    const int row = lane >> 4;
    return v + (row >= 1 ? r0 : 0u) + (row >= 2 ? r1 : 0u) + (row >= 3 ? r2 : 0u); }
__device__ __forceinline__ float bf2f(unsigned short u) { return __builtin_bit_cast(float, (unsigned)u << 16); }
__device__ __forceinline__ float bflo(unsigned w) { return __builtin_bit_cast(float, w << 16); }
__device__ __forceinline__ float bfhi(unsigned w) { return __builtin_bit_cast(float, w & 0xffff0000u); }
__device__ __forceinline__ float fsigmoid(float v) { return __builtin_amdgcn_rcpf(1.f + __expf(-v)); }

struct Ptrs {
    const float *x, *w_in, *kvg, *w_uv, *w_a, *conv_w, *conv_b, *wga, *bga, *wgx, *bgx, *lam, *w_b, *relb, *w_o, *ln_g, *ln_b;
    float* out; unsigned char* ws;
    bf16_t *WinT, *WuvT, *WaT, *WbT, *WoT, *WgaT, *WgxT, *QL, *CKV, *AG, *QI, *KI, *XR, *RG, *GB, *XB, *GA;
    float *WI, *CKVF, *BT;
};

struct EpiProj {
    Ptrs P;
    __device__ __forceinline__ void operator()(const f32x4 (&acc)[2][2][4][2], const pg8::Unit& u, int wr, int wc, int fr, int fq) const {
        const int pn = u.pn; const int row0 = u.pm * 256 + wr * 64 + fr, cl0 = wc * 32 + 8 * fq;
        int kind = 0, ld = 0, coff = 0; bf16_t* dst = nullptr;
        if (pn < 16) { dst = P.QL; ld = 4096; coff = pn * 256; }
        else if (pn == 16) { kind = 3; }
        else if (pn < 25) { dst = P.AG; ld = 2048; coff = (pn - 17) * 256; kind = 1; }
        else if (pn < 29) { dst = P.QI; ld = 1024; coff = (pn - 25) * 256; }
        else if (pn == 29) { kind = 4; }
        else if (pn < 38) { dst = P.XR; ld = 2048; coff = (pn - 30) * 256; }
        else if (pn < 46) { dst = P.RG; ld = 2048; coff = (pn - 38) * 256; kind = 1; }
        else if (pn < 54) { dst = P.GA; ld = 2048; coff = (pn - 46) * 256; kind = 2; }
        else { dst = P.GB; ld = 2048; coff = (pn - 54) * 256; kind = 2; }
#pragma unroll
        for (int ai = 0; ai < 2; ++ai)
#pragma unroll
            for (int m = 0; m < 4; ++m) { const size_t row = (size_t)(row0 + ai * 128 + m * 16);
#pragma unroll
                for (int bj = 0; bj < 2; ++bj) { const int cl = cl0 + bj * 128; f32x4 v0 = acc[ai][bj][m][0], v1 = acc[ai][bj][m][1];
                    if (kind <= 2) {
                        if (kind == 1) {
#pragma unroll
                            for (int e = 0; e < 4; ++e) { v0[e] = v0[e] * fsigmoid(v0[e]); v1[e] = v1[e] * fsigmoid(v1[e]); }
                        } else if (kind == 2) {
#pragma unroll
                            for (int e = 0; e < 4; ++e) { v0[e] = fsigmoid(v0[e]); v1[e] = fsigmoid(v1[e]); }
                        }
                        u32x4 w; w.x = cvt_pk_bf16(v0[0], v0[1]); w.y = cvt_pk_bf16(v0[2], v0[3]); w.z = cvt_pk_bf16(v1[0], v1[1]); w.w = cvt_pk_bf16(v1[2], v1[3]);
                        *(u32x4*)(dst + row * ld + coff + cl) = w;
                    } else if (kind == 3) {
                        float* p = P.CKVF + row * 256 + cl; *(f32x4*)p = v0; *(f32x4*)(p + 4) = v1;
                    } else {
                        if (cl < 64) { u32x4 w; w.x = cvt_pk_bf16(v0[0], v0[1]); w.y = cvt_pk_bf16(v0[2], v0[3]); w.z = cvt_pk_bf16(v1[0], v1[1]); w.w = cvt_pk_bf16(v1[2], v1[3]);
                            *(u32x4*)(P.KI + row * 64 + cl) = w; }
                        else if (cl < 80) { float* p = P.WI + row * 16 + (cl - 64); *(f32x4*)p = v0; *(f32x4*)(p + 4) = v1; }
                    }
                } }
    }
};
template <int MODE> struct EpiGate {
    bf16_t* O; const bf16_t* G;
    __device__ __forceinline__ void operator()(const f32x4 (&acc)[2][2][4][2], const pg8::Unit& u, int wr, int wc, int fr, int fq) const {
        const int row0 = u.pm * 256 + wr * 64 + fr, col0 = u.pn * 256 + wc * 32 + 8 * fq;
#pragma unroll
        for (int ai = 0; ai < 2; ++ai)
#pragma unroll
            for (int m = 0; m < 4; ++m) { const size_t row = (size_t)(row0 + ai * 128 + m * 16);
#pragma unroll
                for (int bj = 0; bj < 2; ++bj) { const size_t off = row * 2048 + col0 + bj * 128; const f32x4 v0 = acc[ai][bj][m][0], v1 = acc[ai][bj][m][1];
                    float r[8];
                    if (MODE == 0) { const u32x4 o = *(const u32x4*)(O + off);
                        r[0] = bflo(o.x) * v0[0]; r[1] = bfhi(o.x) * v0[1]; r[2] = bflo(o.y) * v0[2]; r[3] = bfhi(o.y) * v0[3];
                        r[4] = bflo(o.z) * v1[0]; r[5] = bfhi(o.z) * v1[1]; r[6] = bflo(o.w) * v1[2]; r[7] = bfhi(o.w) * v1[3]; }
                    else { const u32x4 gq = *(const u32x4*)(G + off);
                        r[0] = bflo(gq.x) * v0[0]; r[1] = bfhi(gq.x) * v0[1]; r[2] = bflo(gq.y) * v0[2]; r[3] = bfhi(gq.y) * v0[3];
                        r[4] = bflo(gq.z) * v1[0]; r[5] = bfhi(gq.z) * v1[1]; r[6] = bflo(gq.w) * v1[2]; r[7] = bfhi(gq.w) * v1[3];
                        if (MODE == 2) { const u32x4 o = *(const u32x4*)(O + off);
                            r[0] += bflo(o.x); r[1] += bfhi(o.x); r[2] += bflo(o.y); r[3] += bfhi(o.y); r[4] += bflo(o.z); r[5] += bfhi(o.z); r[6] += bflo(o.w); r[7] += bfhi(o.w); } }
                    u32x4 w; w.x = cvt_pk_bf16(r[0], r[1]); w.y = cvt_pk_bf16(r[2], r[3]); w.z = cvt_pk_bf16(r[4], r[5]); w.w = cvt_pk_bf16(r[6], r[7]);
                    *(u32x4*)(O + off) = w; } }
    }
};
struct EpiOut {
    const float* X; float* Y;
    __device__ __forceinline__ void operator()(const f32x4 (&acc)[2][2][4][2], const pg8::Unit& u, int wr, int wc, int fr, int fq) const {
        const int row0 = u.pm * 256 + wr * 64 + fr, col0 = u.pn * 256 + wc * 32 + 8 * fq;
#pragma unroll
        for (int ai = 0; ai < 2; ++ai)
#pragma unroll
            for (int m = 0; m < 4; ++m) { const size_t row = (size_t)(row0 + ai * 128 + m * 16);
#pragma unroll
                for (int bj = 0; bj < 2; ++bj) { const size_t off = row * 2048 + col0 + bj * 128;
                    const f32x4 x0 = *(const f32x4*)(X + off), x1 = *(const f32x4*)(X + off + 4);
                    *(f32x4*)(Y + off) = x0 * ALPHA + acc[ai][bj][m][0]; *(f32x4*)(Y + off + 4) = x1 * ALPHA + acc[ai][bj][m][1]; } }
    }
};

__device__ __forceinline__ void tr_item(const float* W, int ldw, int k0, int n0, int nv, bf16_t* WT, int ldt, int drow0, int dcol0, float* scr, int lane) {
    float wv[32];
#pragma unroll
    for (int i = 0; i < 32; ++i) { const int kk = 2 * i + (lane >> 5), nn = lane & 31; wv[i] = nn < nv ? W[(size_t)(k0 + kk) * ldw + n0 + nn] : 0.f; }
#pragma unroll
    for (int i = 0; i < 32; ++i) { const int kk = 2 * i + (lane >> 5), nn = lane & 31; scr[kk * 33 + nn] = wv[i]; }
    asm volatile("s_waitcnt lgkmcnt(0)" ::: "memory");
    const int c = lane & 7;
#pragma unroll
    for (int j = 0; j < 4; ++j) { const int n = (lane >> 3) + 8 * j; const float* s = scr + (8 * c) * 33 + n;
        u32x4 o; o.x = cvt_pk_bf16(s[0 * 33], s[1 * 33]); o.y = cvt_pk_bf16(s[2 * 33], s[3 * 33]); o.z = cvt_pk_bf16(s[4 * 33], s[5 * 33]); o.w = cvt_pk_bf16(s[6 * 33], s[7 * 33]);
        if (n < nv) *(u32x4*)(WT + (size_t)(drow0 + n) * ldt + dcol0 + k0 + 8 * c) = o; }
    asm volatile("s_waitcnt lgkmcnt(0)" ::: "memory");
}
__device__ __forceinline__ void p0_prologue(const Ptrs& P, unsigned char* lds, int tid, int G) {
    const int lane = tid & 63, wave = __builtin_amdgcn_readfirstlane(tid >> 6);
    float* scr = (float*)(lds + wave * 8448);
    const int gw = blockIdx.x * 8 + wave, NGW = G * 8;
    for (int it = gw; it < 491 * 32; it += NGW) { const int ci = it >> 5, kb = it & 31; int n0, nv = 32, dr;
        if (ci < 234) { n0 = 32 * ci; dr = n0; } else if (ci == 234) { n0 = 7488; nv = 16; dr = n0; } else { n0 = 7504 + 32 * (ci - 235); dr = n0 + 176; }
        tr_item(P.w_in, 15696, 64 * kb, n0, nv, P.WinT, 2048, dr, 0, scr, lane); }
    for (int it = gw; it < 2048; it += NGW) { const int kb = it >> 6, nb = it & 63; tr_item(P.w_a, 2048, 64 * kb, 32 * nb, 32, P.WaT, 2048, 32 * nb, 0, scr, lane); }
    for (int it = gw; it < 2048; it += NGW) { const int kb = it >> 6, nb = it & 63; tr_item(P.w_b, 2048, 64 * kb, 32 * nb, 32, P.WbT, 2048, 32 * nb, 0, scr, lane); }
    for (int it = gw; it < 2048; it += NGW) { const int kb = it >> 6, nb = it & 63; tr_item(P.w_o, 2048, 64 * kb, 32 * nb, 32, P.WoT, 2048, 32 * nb, 0, scr, lane); }
    for (int it = gw; it < 256; it += NGW) { const int h = it >> 4, kb = (it >> 2) & 3, nb = it & 3;
        tr_item(P.w_uv + (size_t)h * 32768, 128, 64 * kb, 32 * nb, 32, P.WuvT, 512, h * 128 + 32 * nb, (h & 1) * 256, scr, lane); }
    for (int it = gw; it < 128; it += NGW) { const int n = (it >> 3) & 15, kb = (it >> 2) & 1, nb = it & 3;
        tr_item(P.wga + (size_t)n * 16384, 128, 64 * kb, 32 * nb, 32, P.WgaT, 128, n * 128 + 32 * nb, 0, scr, lane); }
    for (int it = gw; it < 128; it += NGW) { const int n = (it >> 3) & 15, kb = (it >> 2) & 1, nb = it & 3;
        tr_item(P.wgx + (size_t)n * 16384, 128, 64 * kb, 32 * nb, 32, P.WgxT, 128, n * 128 + 32 * nb, 0, scr, lane); }
    const size_t gt = (size_t)blockIdx.x * 512 + tid, GT = (size_t)G * 512;
    const u32x4 z = {0u, 0u, 0u, 0u};
    for (size_t i = gt; i < 176 * 256; i += GT) *(u32x4*)(P.WinT + (size_t)7504 * 2048 + i * 8) = z;
    for (size_t i = gt; i < 2048 * 32; i += GT) { const size_t r = i >> 5, c = i & 31; *(u32x4*)(P.WuvT + r * 512 + ((((r >> 7) & 1) ^ 1) * 256) + c * 8) = z; }
#pragma unroll 4
    for (size_t i = gt; i < (size_t)M * D / 8; i += GT) { const f32x4 a = *(const f32x4*)(P.x + i * 8), b = *(const f32x4*)(P.x + i * 8 + 4);
        u32x4 w; w.x = cvt_pk_bf16(a[0], a[1]); w.y = cvt_pk_bf16(a[2], a[3]); w.z = cvt_pk_bf16(b[0], b[1]); w.w = cvt_pk_bf16(b[2], b[3]); *(u32x4*)(P.XB + i * 8) = w; }
    for (size_t i = gt; i < 129 * 16; i += GT) { const int n = (int)(i >> 4), h = (int)(i & 15); int bk;
        if (n < 16) bk = n; else { bk = 16 + (int)(logf((float)n / 16.f) / 2.0794415416798357f * 16.f); bk = bk > 31 ? 31 : bk; }
        P.BT[i] = P.relb[bk * 16 + h]; }
}

__device__ __forceinline__ void ckv_norm_rows(const Ptrs& P, int row0, int nrows, int tid) {
    const int lane = tid & 63, wave = tid >> 6;
    const f32x4 gq = *(const f32x4*)(P.kvg + 4 * lane);
    for (int r0 = wave; r0 < nrows; r0 += 64) {
        f32x4 v[8];
#pragma unroll
        for (int k = 0; k < 8; ++k) { const int r = r0 + 8 * k; v[k] = *(const f32x4*)(P.CKVF + ((size_t)row0 + (r < nrows ? r : r0)) * 256 + 4 * lane); }
#pragma unroll
        for (int k = 0; k < 8; ++k) { const int r = r0 + 8 * k;
            float s = v[k][0] * v[k][0] + v[k][1] * v[k][1] + v[k][2] * v[k][2] + v[k][3] * v[k][3];
            s = rows4_sum(row16_sum(s));
            const float rs = 1.f / sqrtf(s * (1.f / 256.f) + LN_EPS);
            uint2 w; w.x = cvt_pk_bf16(v[k][0] * rs * gq[0], v[k][1] * rs * gq[1]); w.y = cvt_pk_bf16(v[k][2] * rs * gq[2], v[k][3] * rs * gq[3]);
            if (r < nrows) *(uint2*)(P.CKV + ((size_t)row0 + r) * 256 + 4 * lane) = w; }
    }
}

__device__ __forceinline__ float em1_poly(float x) { return x * (1.f + x * (0.5f + x * (0.16666667f + x * (0.041666668f + x * (0.0083333338f + x * 0.0013888889f))))); }
#define BAR_LDS() asm volatile("s_waitcnt lgkmcnt(0)\n\ts_barrier" ::: "memory")
__device__ __forceinline__ void rglru_item(const Ptrs& P, unsigned char* lds, int b, int n, int tid) {
    const int lane = tid & 63, w = __builtin_amdgcn_readfirstlane(tid >> 6), g = lane >> 4, r16 = lane & 15;
    bf16_t* XCb = (bf16_t*)lds;
    float* XCf = (float*)(lds + 17408);
    float* LA = (float*)(lds + 17408 + 32768);
    float* LB = LA + 8192;
    const size_t rowb = (size_t)b * T;
    const int ce = 16 * w + r16, ch = n * 128 + ce;
    bf16x8 Ba[4], Bx[4];
#pragma unroll
    for (int ks = 0; ks < 4; ++ks) { Ba[ks] = *(const bf16x8*)(P.WgaT + (size_t)ch * 128 + 32 * ks + 8 * g); Bx[ks] = *(const bf16x8*)(P.WgxT + (size_t)ch * 128 + 32 * ks + 8 * g); }
    const float ba = P.bga[ch], bx = P.bgx[ch];
    const float sp8 = 8.f * log1pf(expf(-P.lam[ch]));
    const bool big = __any(sp8 > 0.14f);
    float h = 0.f;
    const int tt = tid >> 3, c0 = (tid & 7) * 16, cg0 = n * 128 + c0;
    u32x4 xr[4][2];
#define RG_LOAD(T0) do { _Pragma("unroll") for (int k = 0; k < 4; ++k) { int tk = (T0) + tt - 3 + k; tk = tk < 0 ? 0 : tk; const bf16_t* xp = P.XR + (rowb + tk) * 2048 + cg0; \
            xr[k][0] = *(const u32x4*)xp; xr[k][1] = *(const u32x4*)(xp + 8); } } while (0)
    RG_LOAD(0);
    for (int chunk = 0; chunk < T / 64; ++chunk) {
        const int t0 = chunk * 64;
        u32x4 gc0, gc1;
        {
            float xc[16];
#pragma unroll
            for (int e = 0; e < 16; e += 4) { const f32x4 v = *(const f32x4*)(P.conv_b + cg0 + e); xc[e] = v[0]; xc[e + 1] = v[1]; xc[e + 2] = v[2]; xc[e + 3] = v[3]; }
#pragma unroll
            for (int k = 0; k < 4; ++k) { const float m = (t0 + tt - 3 + k) >= 0 ? 1.f : 0.f;
                float cwk[16];
#pragma unroll
                for (int e = 0; e < 16; e += 4) { const f32x4 c = *(const f32x4*)(P.conv_w + k * 2048 + cg0 + e); cwk[e] = c[0]; cwk[e + 1] = c[1]; cwk[e + 2] = c[2]; cwk[e + 3] = c[3]; }
                const u32x4 xa = xr[k][0], xb2 = xr[k][1];
                const float xv[16] = {bflo(xa.x), bfhi(xa.x), bflo(xa.y), bfhi(xa.y), bflo(xa.z), bfhi(xa.z), bflo(xa.w), bfhi(xa.w),
                                      bflo(xb2.x), bfhi(xb2.x), bflo(xb2.y), bfhi(xb2.y), bflo(xb2.z), bfhi(xb2.z), bflo(xb2.w), bfhi(xb2.w)};
#pragma unroll
                for (int e = 0; e < 16; ++e) xc[e] += (cwk[e] * m) * xv[e]; }
#pragma unroll
            for (int e = 0; e < 16; e += 4) *(f32x4*)(XCf + tt * 128 + c0 + e) = (f32x4){xc[e], xc[e + 1], xc[e + 2], xc[e + 3]};
            u32x4 w0, w1; w0.x = cvt_pk_bf16(xc[0], xc[1]); w0.y = cvt_pk_bf16(xc[2], xc[3]); w0.z = cvt_pk_bf16(xc[4], xc[5]); w0.w = cvt_pk_bf16(xc[6], xc[7]);
            w1.x = cvt_pk_bf16(xc[8], xc[9]); w1.y = cvt_pk_bf16(xc[10], xc[11]); w1.z = cvt_pk_bf16(xc[12], xc[13]); w1.w = cvt_pk_bf16(xc[14], xc[15]);
            *(u32x4*)(XCb + tt * 136 + c0) = w0; *(u32x4*)(XCb + tt * 136 + c0 + 8) = w1;
            { const bf16_t* gp_ = P.RG + (rowb + t0 + tt) * 2048 + cg0; gc0 = *(const u32x4*)gp_; gc1 = *(const u32x4*)(gp_ + 8); }
            if (chunk + 1 < T / 64) RG_LOAD(t0 + 64);
        }
        BAR_LDS();
#pragma unroll
        for (int mt = 0; mt < 4; ++mt) {
            f32x4 ar = {0.f, 0.f, 0.f, 0.f}, ai = {0.f, 0.f, 0.f, 0.f};
#pragma unroll
            for (int ks = 0; ks < 4; ++ks) { const bf16x8 A = *(const bf16x8*)(XCb + (16 * mt + r16) * 136 + 32 * ks + 8 * g);
                ar = mfma16(A, Ba[ks], ar); ai = mfma16(A, Bx[ks], ai); }
#pragma unroll
            for (int j = 0; j < 4; ++j) { const int tok = 16 * mt + 4 * g + j;
                const float r = fsigmoid(ar[j] + ba), ig = fsigmoid(ai[j] + bx);
                const float la = -sp8 * r;
                float a, m2;
                (void)big; a = __expf(la); m2 = __builtin_fmaf(-a, a, 1.f);
                float mult = sqrtf(fmaxf(m2, 0.f)); if (t0 + tok == 0) mult = 1.f;
                LA[tok * 128 + ce] = a; LB[tok * 128 + ce] = mult * ig * XCf[tok * 128 + ce]; }
        }
        BAR_LDS();
        if (tid < 128) {
#pragma unroll 1
            for (int t16 = 0; t16 < 64; t16 += 16) { float av[16], bv[16];
#pragma unroll
                for (int e = 0; e < 16; ++e) { av[e] = LA[(t16 + e) * 128 + tid]; bv[e] = LB[(t16 + e) * 128 + tid]; }
#pragma unroll
                for (int e = 0; e < 16; ++e) { h = av[e] * h + bv[e]; LB[(t16 + e) * 128 + tid] = h; } }
        }
        BAR_LDS();
        {
            bf16_t* gp = P.RG + (rowb + t0 + tt) * 2048 + cg0;
            const float* hp = LB + tt * 128 + c0;
            u32x4 o0, o1;
            o0.x = cvt_pk_bf16(hp[0] * bflo(gc0.x), hp[1] * bfhi(gc0.x)); o0.y = cvt_pk_bf16(hp[2] * bflo(gc0.y), hp[3] * bfhi(gc0.y));
            o0.z = cvt_pk_bf16(hp[4] * bflo(gc0.z), hp[5] * bfhi(gc0.z)); o0.w = cvt_pk_bf16(hp[6] * bflo(gc0.w), hp[7] * bfhi(gc0.w));
            o1.x = cvt_pk_bf16(hp[8] * bflo(gc1.x), hp[9] * bfhi(gc1.x)); o1.y = cvt_pk_bf16(hp[10] * bflo(gc1.y), hp[11] * bfhi(gc1.y));
            o1.z = cvt_pk_bf16(hp[12] * bflo(gc1.z), hp[13] * bfhi(gc1.z)); o1.w = cvt_pk_bf16(hp[14] * bflo(gc1.w), hp[15] * bfhi(gc1.w));
            *(u32x4*)gp = o0; *(u32x4*)(gp + 8) = o1;
        }
    }
#undef RG_LOAD
    __syncthreads();
}

__device__ __forceinline__ unsigned f2key(float f) { const unsigned u = __builtin_bit_cast(unsigned, f); return (u & 0x80000000u) ? ~u : (u | 0x80000000u); }
__device__ __forceinline__ unsigned mbcnt64(unsigned long long m) { return __builtin_amdgcn_mbcnt_hi((unsigned)(m >> 32), __builtin_amdgcn_mbcnt_lo((unsigned)m, 0u)); }
__device__ __forceinline__ bf16x8 tr_read2(unsigned a0, unsigned a1) {
    s16x4 r0, r1;
    asm volatile("ds_read_b64_tr_b16 %0, %2\n\tds_read_b64_tr_b16 %1, %3\n\ts_waitcnt lgkmcnt(0)" : "=&v"(r0), "=&v"(r1) : "v"(a0), "v"(a1) : "memory");
    bf16x8 r; r[0] = r0[0]; r[1] = r0[1]; r[2] = r0[2]; r[3] = r0[3]; r[4] = r1[0]; r[5] = r1[1]; r[6] = r1[2]; r[7] = r1[3]; return r;
}
__device__ __forceinline__ void attn_item(const Ptrs& P, unsigned char* lds, int b, int tq0, int tid) {
    const int lane = tid & 63, w = __builtin_amdgcn_readfirstlane(tid >> 6), g = lane >> 4, r16 = lane & 15;
    constexpr int SP = 264;
    bf16_t* stg = (bf16_t*)lds;
    unsigned char* l2 = lds + 135168;
    unsigned short* sel = (unsigned short*)l2;
    unsigned* cntw = (unsigned*)(l2 + 2048);
    unsigned* gte = (unsigned*)(l2 + 2048 + 256);
    bf16_t* Pm = (bf16_t*)(l2 + 4096);
    const size_t rowb = (size_t)b * T;
    const int tmax = tq0 + 3;
    if (tmax < 256 || (DBG & 4)) {
        for (int i = tid; i < 1024; i += 512) sel[i] = (unsigned short)(((i & 255) <= tq0 + (i >> 8)) ? (i & 255) : 0);
        __syncthreads();
    } else {
        bf16x8 Aq[4][2]; f32x4 wq[4];
#pragma unroll
        for (int q = 0; q < 4; ++q) { const bf16_t* qp = P.QI + (rowb + tq0 + q) * 1024 + r16 * 64 + 8 * g; Aq[q][0] = *(const bf16x8*)qp; Aq[q][1] = *(const bf16x8*)(qp + 32);
            wq[q] = *(const f32x4*)(P.WI + (rowb + tq0 + q) * 16 + 4 * g); }
        unsigned* KB = (unsigned*)lds;
        const int nch = (tmax >> 6) + 1;
        const int ni = (w < nch) ? ((nch - w + 7) >> 3) : 0;
        bf16x8 Bk[4][2];
#define TILE_LOAD(SLOT, CC, TT) do { const bf16_t* kp = P.KI + (rowb + 64 * (CC) + 16 * (TT) + r16) * 64 + 8 * g; Bk[SLOT][0] = *(const bf16x8*)kp; Bk[SLOT][1] = *(const bf16x8*)(kp + 32); } while (0)
#define TILE_MATH(SLOT, TT) do { _Pragma("unroll") for (int q = 0; q < 4; ++q) { f32x4 a = {0.f, 0.f, 0.f, 0.f}; \
            a = mfma16(Aq[q][0], Bk[SLOT][0], a); a = mfma16(Aq[q][1], Bk[SLOT][1], a); \
            pv[q][TT] = wq[q][0] * fmaxf(a[0], 0.f) + wq[q][1] * fmaxf(a[1], 0.f) + wq[q][2] * fmaxf(a[2], 0.f) + wq[q][3] * fmaxf(a[3], 0.f); } } while (0)
        if (ni > 0) { TILE_LOAD(0, w, 0); TILE_LOAD(1, w, 1); }
#pragma unroll 1
        for (int it = 0; it < ni; ++it) {
            const int c = 8 * it + w; const bool more = it + 1 < ni;
            float pv[4][4], sv[4];
            TILE_LOAD(2, c, 2); TILE_MATH(0, 0);
            TILE_LOAD(3, c, 3); TILE_MATH(1, 1);
            if (more) TILE_LOAD(0, c + 8, 0);
            TILE_MATH(2, 2);
            if (more) TILE_LOAD(1, c + 8, 1);
            TILE_MATH(3, 3);
#pragma unroll
            for (int q = 0; q < 4; ++q) { float a0 = pv[q][0], b0 = pv[q][2], a1 = pv[q][1], b1 = pv[q][3];
                asm("s_nop 1\n\tv_permlane32_swap_b32 %0, %1" : "+v"(a0), "+v"(b0));
                asm("s_nop 1\n\tv_permlane32_swap_b32 %0, %1" : "+v"(a1), "+v"(b1));
                float x = a0 + b0, y = a1 + b1;
                asm("s_nop 1\n\tv_permlane16_swap_b32 %0, %1" : "+v"(x), "+v"(y));
                sv[q] = x + y; }
            const int s = 64 * c + lane;
#pragma unroll
            for (int q = 0; q < 4; ++q) KB[q * 8192 + s] = (s <= tq0 + q) ? f2key(sv[q]) : 0u;
        }
#undef TILE_LOAD
#undef TILE_MATH
        __syncthreads();
        const int qs = w >> 1, hs = w & 1;
        unsigned k2[64];
#pragma unroll
        for (int r = 0; r < 64; ++r) k2[r] = KB[qs * 8192 + 64 * (2 * r + hs) + lane];
        __syncthreads();
#pragma unroll
        for (int r = 0; r < 64; ++r) k2[r] = (2 * r + hs < nch) ? k2[r] : 0u;
        const int nact = (nch + 1 - hs) >> 1;
        volatile unsigned* xw = (volatile unsigned*)(lds + 147456);
        const unsigned seq = (xw[32 + w] + 1u) & 0xffu; if (lane == 0) xw[32 + w] = seq;
#define PAIR_XCHG(SLOT, TAG, MINE, OTHER) do { const unsigned tg_ = (seq << 8) | (unsigned)(TAG); if (lane == 0) xw[w * 4 + (SLOT)] = ((MINE) << 16) | tg_; \
            unsigned v_; do { v_ = xw[(w ^ 1) * 4 + (SLOT)]; } while ((v_ & 0xffffu) != tg_); OTHER = v_ >> 16; } while (0)
        unsigned th = 0u;
        for (int bit = 31; bit >= 0; --bit) {
            const unsigned cand = th | (1u << bit); unsigned cnt = 0, oth;
#pragma unroll
            for (int k = 0; k < 4; ++k) if (16 * k < nact) {
#pragma unroll
                for (int r = 16 * k; r < 16 * k + 16; ++r) cnt += (unsigned)__popcll(__ballot(k2[r] >= cand)); }
            PAIR_XCHG(bit & 1, 1 + bit, cnt, oth);
            cnt += oth;
            if (cnt >= 256u) th = cand;
            if (cnt == 256u) break;
        }
        unsigned cg = 0, ce = 0;
#pragma unroll
        for (int k = 0; k < 4; ++k) if (16 * k < nact) {
#pragma unroll
            for (int r = 16 * k; r < 16 * k + 16; ++r) { cg += (k2[r] > th) ? 1u : 0u; ce += (k2[r] == th) ? 1u : 0u; } }
        const unsigned ig = wave_incl_scan(cg, lane), ie = wave_incl_scan(ce, lane);
        const unsigned ngt = (unsigned)__builtin_amdgcn_readlane((int)ig, 63), neq = (unsigned)__builtin_amdgcn_readlane((int)ie, 63);
        unsigned ogt, oeq;
        PAIR_XCHG(2, 40, ngt, ogt); PAIR_XCHG(3, 41, neq, oeq);
        const unsigned tot_gt = ngt + ogt, quota = 256u - tot_gt;
        unsigned pos_g = (hs ? ogt : 0u) + ig - cg, pos_e = (hs ? oeq : 0u) + ie - ce;
        const bool any_eq = (neq + oeq) != 0u;
#pragma unroll
        for (int k = 0; k < 4; ++k) if (16 * k < nact) {
#pragma unroll
            for (int r = 16 * k; r < 16 * k + 16; ++r) { const unsigned short idx = (unsigned short)(64 * (2 * r + hs) + lane);
                if (k2[r] > th) { sel[qs * 256 + pos_g] = idx; ++pos_g; }
                if (any_eq) { if (k2[r] == th) { if (pos_e < quota) sel[qs * 256 + tot_gt + pos_e] = idx; ++pos_e; } } } }
        { unsigned dn_; PAIR_XCHG(0, 42, 0u, dn_); (void)dn_; }
#undef PAIR_XCHG
    }
    const int q = w >> 1, half = w & 1, tq = tq0 + q;
    const int nsel = tq + 1 < 256 ? tq + 1 : 256;
    bf16x8 Af[8];
    {
        const bf16_t* qlp = P.QL + (rowb + tq) * 4096 + r16 * 256 + 8 * g;
#pragma unroll
        for (int ks = 0; ks < 8; ++ks) Af[ks] = *(const bf16x8*)(qlp + 32 * ks);
    }
    bf16_t* stw = stg + w * 32 * SP;
    bf16_t* Pw = (bf16_t*)(l2 + 2048) + w * 16 * 40;
    volatile unsigned* xa = (volatile unsigned*)(lds + 147456);
    const unsigned aseq = (xa[40 + w] + 1u) & 0xffffu; if (lane == 0) xa[40 + w] = aseq;
    float mrun[4], lrun[4];
#pragma unroll
    for (int j = 0; j < 4; ++j) { mrun[j] = -1e30f; lrun[j] = 0.f; }
    f32x4 oacc[16];
#pragma unroll
    for (int dt = 0; dt < 16; ++dt) oacc[dt] = (f32x4){0.f, 0.f, 0.f, 0.f};
    const int qq = r16 >> 2, pp4 = lane & 3;
    const unsigned tr_base = (unsigned)(uintptr_t)stw + (unsigned)(((8 * g + qq) * SP + 4 * pp4) * 2);
    const int slot0 = 128 * half;
#define STG_LOAD(CK) do { _Pragma("unroll") for (int it = 0; it < 16; ++it) { const int pp = it * 64 + lane, kk = pp >> 5, cp = pp & 31; \
        const int idx = (int)sel[q * 256 + slot0 + 32 * (CK) + kk]; stv[it] = *(const u32x4*)(P.CKV + (rowb + idx) * 256 + 8 * cp); } } while (0)
#define TR8(R, OFF) asm volatile( \
            "ds_read_b64_tr_b16 %0, %8 offset:" #OFF "+0\n\tds_read_b64_tr_b16 %1, %8 offset:" #OFF "+2112\n\t" \
            "ds_read_b64_tr_b16 %2, %8 offset:" #OFF "+32\n\tds_read_b64_tr_b16 %3, %8 offset:" #OFF "+2144\n\t" \
            "ds_read_b64_tr_b16 %4, %8 offset:" #OFF "+64\n\tds_read_b64_tr_b16 %5, %8 offset:" #OFF "+2176\n\t" \
            "ds_read_b64_tr_b16 %6, %8 offset:" #OFF "+96\n\tds_read_b64_tr_b16 %7, %8 offset:" #OFF "+2208\n\t" \
            "s_waitcnt lgkmcnt(0)" \
            : "=&v"(R[0]), "=&v"(R[1]), "=&v"(R[2]), "=&v"(R[3]), "=&v"(R[4]), "=&v"(R[5]), "=&v"(R[6]), "=&v"(R[7]) \
            : "v"(tr_base) : "memory")
    u32x4 stv[16];
    STG_LOAD(0);
#pragma unroll 1
    for (int ck = 0; ck < 4; ++ck) {
#pragma unroll
        for (int it = 0; it < 16; ++it) { const int pp = it * 64 + lane, kk = pp >> 5, cp = pp & 31; *(u32x4*)(stw + kk * SP + 8 * cp) = stv[it]; }
        if (ck < 3) STG_LOAD(ck + 1);
        asm volatile("s_waitcnt lgkmcnt(0)" ::: "memory");
        f32x4 sc[2];
#pragma unroll
        for (int k2 = 0; k2 < 2; ++k2) {
            const int slot = slot0 + 32 * ck + 16 * k2 + r16; const bool valid = slot < nsel; const int idx = (int)sel[q * 256 + slot];
            int dist = tq - idx; dist = dist > 128 ? 128 : dist; dist = dist < 0 ? 0 : dist;
            const f32x4 bb = *(const f32x4*)(P.BT + dist * 16 + 4 * g);
            const bf16_t* kp = stw + (16 * k2 + r16) * SP + 8 * g;
            f32x4 a = {0.f, 0.f, 0.f, 0.f};
#pragma unroll
            for (int ks = 0; ks < 8; ++ks) a = mfma16(Af[ks], *(const bf16x8*)(kp + 32 * ks), a);
#pragma unroll
            for (int j = 0; j < 4; ++j) a[j] = valid ? a[j] * 0.0625f + bb[j] : -1e30f;
            sc[k2] = a;
        }
#pragma unroll
        for (int j = 0; j < 4; ++j) {
            const float mn = fmaxf(mrun[j], row16_max(fmaxf(sc[0][j], sc[1][j])));
            const float scale = __expf(mrun[j] - mn);
            const float p0 = __expf(sc[0][j] - mn), p1 = __expf(sc[1][j] - mn);
            lrun[j] = lrun[j] * scale + row16_sum(p0 + p1);
            mrun[j] = mn;
#pragma unroll
            for (int dt = 0; dt < 16; ++dt) oacc[dt][j] *= scale;
            Pw[(4 * g + j) * 40 + r16] = (bf16_t)(cvt_pk_bf16(p0, 0.f) & 0xffffu);
            Pw[(4 * g + j) * 40 + 16 + r16] = (bf16_t)(cvt_pk_bf16(p1, 0.f) & 0xffffu);
        }
        asm volatile("s_waitcnt lgkmcnt(0)" ::: "memory");
        const bf16x8 Ap = *(const bf16x8*)(Pw + r16 * 40 + 8 * g);
#pragma unroll
        for (int hh = 0; hh < 4; ++hh) {
            s16x4 r[8];
            if (hh == 0) TR8(r, 0); else if (hh == 1) TR8(r, 128); else if (hh == 2) TR8(r, 256); else TR8(r, 384);
#pragma unroll
            for (int dt = 0; dt < 4; ++dt) { bf16x8 Bv; Bv[0] = r[2 * dt][0]; Bv[1] = r[2 * dt][1]; Bv[2] = r[2 * dt][2]; Bv[3] = r[2 * dt][3];
                Bv[4] = r[2 * dt + 1][0]; Bv[5] = r[2 * dt + 1][1]; Bv[6] = r[2 * dt + 1][2]; Bv[7] = r[2 * dt + 1][3];
                oacc[4 * hh + dt] = mfma16(Ap, Bv, oacc[4 * hh + dt]); }
        }
    }
#undef STG_LOAD
#undef TR8
    {
        float* cmb = (float*)stw;
#pragma unroll
        for (int dt = 0; dt < 8; ++dt)
#pragma unroll
            for (int j = 0; j < 4; ++j) cmb[(dt * 4 + j) * 64 + lane] = half ? oacc[dt][j] : oacc[8 + dt][j];
#pragma unroll
        for (int j = 0; j < 4; ++j) { cmb[2048 + j * 64 + lane] = mrun[j]; cmb[2304 + j * 64 + lane] = lrun[j]; }
        asm volatile("s_waitcnt lgkmcnt(0)" ::: "memory");
        if (lane == 0) xa[48 + w] = aseq;
        while (xa[48 + (w ^ 1)] != aseq) { }
        const float* pc = (const float*)(stg + (w ^ 1) * 32 * SP);
        float wa[4], wb[4];
#pragma unroll
        for (int j = 0; j < 4; ++j) { const float mo = pc[2048 + j * 64 + lane], lo = pc[2304 + j * 64 + lane];
            const float mm = fmaxf(mrun[j], mo); const float ea = __expf(mrun[j] - mm), eb = __expf(mo - mm);
            const float inv = 1.f / (lrun[j] * ea + lo * eb); wa[j] = ea * inv; wb[j] = eb * inv; }
        bf16_t* op = P.QL + (rowb + tq) * 4096;
#pragma unroll
        for (int dt = 0; dt < 8; ++dt)
#pragma unroll
            for (int j = 0; j < 4; ++j) { const float v = (half ? oacc[8 + dt][j] : oacc[dt][j]) * wa[j] + pc[(dt * 4 + j) * 64 + lane] * wb[j];
                op[(4 * g + j) * 256 + 16 * (8 * half + dt) + r16] = (bf16_t)(cvt_pk_bf16(v, 0.f) & 0xffffu); }
    }
}

__device__ __forceinline__ void ln_rows(const Ptrs& P, int tid, int G) {
    const int lane = tid & 63, gw = blockIdx.x * 8 + (tid >> 6), NGW = G * 8;
    f32x4 gg[8], bb[8];
#pragma unroll
    for (int j = 0; j < 8; ++j) { gg[j] = *(const f32x4*)(P.ln_g + 4 * lane + 256 * j); bb[j] = *(const f32x4*)(P.ln_b + 4 * lane + 256 * j); }
    for (int m = gw; m < M; m += 2 * NGW) {
        const int m1 = m + NGW; const bool two = m1 < M;
        float* y0 = P.out + (size_t)m * D + 4 * lane; float* y1 = P.out + (size_t)(two ? m1 : m) * D + 4 * lane;
        f32x4 v[8], u[8]; float s = 0.f, t = 0.f;
#pragma unroll
        for (int j = 0; j < 8; ++j) { v[j] = *(const f32x4*)(y0 + 256 * j); u[j] = *(const f32x4*)(y1 + 256 * j); }
#pragma unroll
        for (int j = 0; j < 8; ++j) { s += (v[j][0] + v[j][1]) + (v[j][2] + v[j][3]); t += (u[j][0] + u[j][1]) + (u[j][2] + u[j][3]); }
        s = rows4_sum(row16_sum(s)); t = rows4_sum(row16_sum(t));
        const float mean0 = s * (1.f / D), mean1 = t * (1.f / D); float s2 = 0.f, t2 = 0.f;
#pragma unroll
        for (int j = 0; j < 8; ++j) { v[j] = v[j] - mean0; u[j] = u[j] - mean1;
            s2 += (v[j][0] * v[j][0] + v[j][1] * v[j][1]) + (v[j][2] * v[j][2] + v[j][3] * v[j][3]);
            t2 += (u[j][0] * u[j][0] + u[j][1] * u[j][1]) + (u[j][2] * u[j][2] + u[j][3] * u[j][3]); }
        s2 = rows4_sum(row16_sum(s2)); t2 = rows4_sum(row16_sum(t2));
        const float rstd0 = 1.f / sqrtf(s2 * (1.f / D) + LN_EPS), rstd1 = 1.f / sqrtf(t2 * (1.f / D) + LN_EPS);
#pragma unroll
        for (int j = 0; j < 8; ++j) *(f32x4*)(y0 + 256 * j) = v[j] * rstd0 * gg[j] + bb[j];
        if (two) {
#pragma unroll
            for (int j = 0; j < 8; ++j) *(f32x4*)(y1 + 256 * j) = u[j] * rstd1 * gg[j] + bb[j]; }
    }
}

struct Args { const float* in[17]; float* out; unsigned char* ws; int ph_lo, ph_hi; };
constexpr int NPH = 7;

__global__ void __launch_bounds__(512, 2) mega_fwd(Args args) {
    extern __shared__ __attribute__((aligned(16))) unsigned char lds[];
    cg::grid_group grid = cg::this_grid();
    const int tid = threadIdx.x, G = gridDim.x;
    Ptrs P;
    P.x = args.in[0]; P.w_in = args.in[1]; P.kvg = args.in[2]; P.w_uv = args.in[3]; P.w_a = args.in[4]; P.conv_w = args.in[5]; P.conv_b = args.in[6];
    P.wga = args.in[7]; P.bga = args.in[8]; P.wgx = args.in[9]; P.bgx = args.in[10]; P.lam = args.in[11]; P.w_b = args.in[12]; P.relb = args.in[13];
    P.w_o = args.in[14]; P.ln_g = args.in[15]; P.ln_b = args.in[16]; P.out = args.out; P.ws = args.ws;
    unsigned char* ws = args.ws;
    P.WinT = (bf16_t*)(ws + WS_WIN); P.WuvT = (bf16_t*)(ws + WS_WUV); P.WaT = (bf16_t*)(ws + WS_WA); P.WbT = (bf16_t*)(ws + WS_WB); P.WoT = (bf16_t*)(ws + WS_WO);
    P.WgaT = (bf16_t*)(ws + WS_WGA); P.WgxT = (bf16_t*)(ws + WS_WGX); P.QL = (bf16_t*)(ws + WS_QL); P.CKV = (bf16_t*)(ws + WS_CKV); P.AG = (bf16_t*)(ws + WS_AG);
    P.QI = (bf16_t*)(ws + WS_QI); P.KI = (bf16_t*)(ws + WS_KI); P.XR = (bf16_t*)(ws + WS_XR); P.RG = (bf16_t*)(ws + WS_RG); P.GB = (bf16_t*)(ws + WS_GB);
    P.XB = (bf16_t*)args.out; P.GA = (bf16_t*)args.out + (size_t)M * D;
    P.WI = (float*)(ws + WS_WI); P.CKVF = (float*)(ws + WS_CKVF); P.BT = (float*)(ws + WS_BT);
    unsigned* ctl = (unsigned*)(ws + WS_CTL);
    PG8_LAS unsigned char* ldsl = (PG8_LAS unsigned char*)lds;
    const int lo = args.ph_lo, hi = args.ph_hi;
#define IN(k) (lo <= (k) && (k) < hi)
#define SEAM(k) do { if (IN(k) && IN((k) + 1)) grid.sync(); } while (0)

    if (IN(0)) { if (blockIdx.x == 0 && tid < 4) ctl[64 * tid] = 0u; p0_prologue(P, lds, tid, G); }
    SEAM(0);
    if (IN(1)) {
        pg8::Gemm g{P.XB, P.WinT, 2048, 2048, 2048, 0}; pg8::StaticOrder S; S.init(M, NP, G, (int)blockIdx.x);
        EpiProj E{P};
        pg8::gemm_phase<EpiProj>(ldsl, g, S, E);
        pg8::Unit u;
        for (int i = 0; S.next(i, u); ++i) if (u.pn == 16) ckv_norm_rows(P, u.pm * 256, 256, tid);
    }
    SEAM(1);
    if (IN(2) && !(DBG & 1)) {
        if (blockIdx.x < 64) rglru_item(P, lds, (int)blockIdx.x >> 4, (int)blockIdx.x & 15, tid);
        if (tid < 64) ((volatile unsigned*)(lds + 147456))[tid] = 0u;
        __syncthreads();
        const int hb = ((int)blockIdx.x & 7) >> 1;
        for (int k = 0; k < NB; ++k) {
            const int b = (hb + k) & 3;
            for (;;) {
                __syncthreads();
                if (tid == 0) *(volatile int*)(lds + 147712) = (int)atomicAdd(ctl + 64 * b, 1u);
                __syncthreads();
                const int item = *(volatile int*)(lds + 147712);
                if (item >= T / 4) break;
                attn_item(P, lds, b, 4 * ((T / 4 - 1) - item), tid);
            }
        }
    }
    SEAM(2);
    if (IN(3)) {
        pg8::Gemm g{P.QL, P.WuvT, 512, 4096, 512, 512}; pg8::StaticOrder S; S.init(M, 2048, G, (int)blockIdx.x);
        EpiGate<0> E{P.AG, nullptr};
        pg8::gemm_phase<EpiGate<0>, true>(ldsl, g, S, E);
    }
    SEAM(3);
    if (IN(4)) {
        pg8::StaticOrder S; S.init(M, 2048, G, (int)blockIdx.x);
        { pg8::Gemm g{P.AG, P.WaT, 2048, 2048, 2048, 0}; EpiGate<1> E{P.XR, P.GA}; pg8::gemm_phase<EpiGate<1>>(ldsl, g, S, E); }
        { pg8::Gemm g{P.RG, P.WbT, 2048, 2048, 2048, 0}; EpiGate<2> E{P.XR, P.GB}; pg8::gemm_phase<EpiGate<2>>(ldsl, g, S, E); }
    }
    SEAM(4);
    if (IN(5)) {
        pg8::Gemm g{P.XR, P.WoT, 2048, 2048, 2048, 0}; pg8::StaticOrder S; S.init(M, 2048, G, (int)blockIdx.x);
        EpiOut E{P.x, P.out};
        pg8::gemm_phase<EpiOut>(ldsl, g, S, E);
    }
    SEAM(5);
    if (IN(6)) { ln_rows(P, tid, G); }
#undef IN
#undef SEAM
}

extern "C" void kernel_launch(void* const* d_in, const int* in_sizes, int n_in, void* d_out, int out_size, void* d_ws, size_t ws_size, hipStream_t stream) {
    static int grid = 0;
    if (grid == 0) {
        if (n_in != 17 || out_size != M * D || ws_size < WS_END) { fprintf(stderr, "kernel_launch: unexpected shapes (n_in %d out %d ws %zu)\n", n_in, out_size, ws_size); grid = -1; return; }
        int dev = 0, cus = 0, per_cu = 0;
        hipGetDevice(&dev); hipDeviceGetAttribute(&cus, hipDeviceAttributeMultiprocessorCount, dev);
        if (hipFuncSetAttribute((const void*)mega_fwd, hipFuncAttributeMaxDynamicSharedMemorySize, LDS_BYTES) != hipSuccess) { fprintf(stderr, "kernel_launch: hipFuncSetAttribute failed\n"); grid = -1; return; }
        if (hipOccupancyMaxActiveBlocksPerMultiprocessor(&per_cu, (const void*)mega_fwd, 512, LDS_BYTES) != hipSuccess || per_cu < 1) { fprintf(stderr, "kernel_launch: occupancy query says %d\n", per_cu); per_cu = 1; }
        (void)hipGetLastError();
        grid = cus * per_cu;
    }
    if (grid < 0) return;
    Args a{};
    for (int i = 0; i < 17; ++i) a.in[i] = (const float*)d_in[i];
    a.out = (float*)d_out; a.ws = (unsigned char*)d_ws;
#if N_LAUNCHES == 1
    a.ph_lo = 0; a.ph_hi = NPH;
    void* kargs[] = {&a};
    hipError_t e = hipLaunchCooperativeKernel((const void*)mega_fwd, dim3(grid), dim3(512), kargs, LDS_BYTES, stream);
    if (e != hipSuccess) fprintf(stderr, "cooperative launch failed: %s (grid %d)\n", hipGetErrorString(e), grid);
#else
    for (int ph = 0; ph < NPH; ++ph) { a.ph_lo = ph; a.ph_hi = ph + 1;
        hipLaunchKernelGGL(mega_fwd, dim3(grid), dim3(512), LDS_BYTES, stream, a); }
#endif
}
```
